# Optimizing an MI355X kernel written in HIP

```python
import jax, jax.numpy as jnp
from jax import lax
import numpy as np

D_MODEL = 1024
BATCH = 2
SEQ = 8192
DEPTH = 1

RWKV_HEAD = 64
RWKV_HEADS = 8
RWKV_WIDTH = RWKV_HEADS * RWKV_HEAD
DECAY_RANK = 64
ICLR_RANK = 64
ATT_HEAD = 64
ATT_Q_HEADS = 8
ATT_KV_HEADS = 2
ATT_GROUP = ATT_Q_HEADS // ATT_KV_HEADS
ATT_WIDTH = ATT_Q_HEADS * ATT_HEAD
ATT_KV_WIDTH = ATT_KV_HEADS * ATT_HEAD
QKV_WIDTH = ATT_WIDTH + 2 * ATT_KV_WIDTH
WINDOW = 128
BLOCK = 128
N_BRANCHES = 2
SHIFT_WIDTH = 3 * RWKV_WIDTH + DECAY_RANK + ICLR_RANK
IN_COLS = SHIFT_WIDTH + RWKV_WIDTH + QKV_WIDTH + ATT_WIDTH + N_BRANCHES * D_MODEL
RMS_EPS = 1e-6
GN_EPS = 64e-5
L2_EPS = 1e-12
NEG_INF = -1e30

kernel_name = 'hybrid_rwkv7_swa_sink_gated'


def _split(t, sizes):
    out, off = [], 0
    for s in sizes:
        out.append(t[..., off:off + s])
        off += s
    return out


def rms_norm(x, g):
    xf = x.astype(jnp.float32)
    y = xf * lax.rsqrt(jnp.mean(xf * xf, axis=-1, keepdims=True) + RMS_EPS)
    return (y * g.astype(jnp.float32)).astype(x.dtype)


def token_shift(p, mu):
    prev = jnp.pad(p[:, :-1], ((0, 0), (1, 0), (0, 0)))
    return p + (prev - p) * mu


def rwkv7_time_mix(r, k, v, w_lo, a_lo, w0, w_decay_up, a0, w_iclr_up, k_k, k_a, r_k, gn_w, gn_b):
    B, T, _ = r.shape
    f32 = jnp.float32
    H, N = RWKV_HEADS, RWKV_HEAD
    w_log = -jax.nn.softplus(-(w0 + jnp.tanh(w_lo) @ w_decay_up)) - 0.5
    decay = jnp.exp(-jnp.exp(w_log.astype(f32)))
    a = jax.nn.sigmoid(a0 + a_lo @ w_iclr_up)
    kk = (k * k_k).reshape(B, T, H, N).astype(f32)
    kk = kk / jnp.maximum(jnp.sqrt(jnp.sum(kk * kk, axis=-1, keepdims=True)), L2_EPS)
    k = k * (1.0 + (a - 1.0) * k_a)
    rh = r.reshape(B, T, H, N).astype(f32)
    kh = k.reshape(B, T, H, N).astype(f32)
    vh = v.reshape(B, T, H, N).astype(f32)
    wh = decay.reshape(B, T, H, N)
    ah = a.reshape(B, T, H, N).astype(f32)
    tm = lambda t: jnp.moveaxis(t, 1, 0)

    def step(S, inp):
        r_t, w_t, k_t, v_t, kk_t, a_t = inp
        sa = jnp.einsum('bhvk,bhk->bhv', S, kk_t)
        S = (S * w_t[:, :, None, :]
             - sa[..., None] * (kk_t * a_t)[:, :, None, :]
             + v_t[..., None] * k_t[:, :, None, :])
        y_t = jnp.einsum('bhvk,bhk->bhv', S, r_t)
        return S, y_t

    S0 = jnp.zeros((B, H, N, N), f32)
    _, y = lax.scan(step, S0, (tm(rh), tm(wh), tm(kh), tm(vh), tm(kk), tm(ah)))
    y = jnp.moveaxis(y, 0, 1)
    mean = jnp.mean(y, axis=-1, keepdims=True)
    var = jnp.mean(jnp.square(y - mean), axis=-1, keepdims=True)
    y = ((y - mean) * lax.rsqrt(var + GN_EPS)).reshape(B, T, RWKV_WIDTH)
    y = y * gn_w.astype(f32) + gn_b.astype(f32)
    bonus = jnp.sum(rh * kh * r_k.reshape(H, N).astype(f32), axis=-1, keepdims=True) * vh
    return (y + bonus.reshape(B, T, RWKV_WIDTH)).astype(r.dtype)


def sliding_window_sink_attention(q, k, v, sinks):
    B, T, _ = q.shape
    nb = T // BLOCK
    f32 = jnp.float32
    KV, G, Dh = ATT_KV_HEADS, ATT_GROUP, ATT_HEAD
    qb = q.reshape(B, nb, BLOCK, KV, G, Dh)
    k = k.reshape(B, T, KV, Dh)
    v = v.reshape(B, T, KV, Dh)

    def banded(t):
        prev = jnp.pad(t, ((0, 0), (BLOCK, 0), (0, 0), (0, 0)))[:, :T]
        return jnp.concatenate([prev.reshape(B, nb, BLOCK, KV, Dh),
                                t.reshape(B, nb, BLOCK, KV, Dh)], axis=2)

    kb, vb = banded(k), banded(v)
    s = jnp.einsum('bnqhgd,bnkhd->bnhgqk', qb, kb).astype(f32) * (Dh ** -0.5)
    qi = jnp.arange(BLOCK)[:, None]
    kj = jnp.arange(2 * BLOCK)[None, :]
    dist = qi + BLOCK - kj
    band = (dist >= 0) & (dist < WINDOW)
    valid = band[None] & ((jnp.arange(nb)[:, None, None] > 0) | (kj[None] >= BLOCK))
    s = jnp.where(valid[None, :, None, None], s, NEG_INF)
    sink = jnp.broadcast_to(sinks.astype(f32).reshape(1, 1, KV, G, 1, 1), s.shape[:-1] + (1,))
    p = jax.nn.softmax(jnp.concatenate([s, sink], axis=-1), axis=-1)[..., :-1]
    o = jnp.einsum('bnhgqk,bnkhd->bnqhgd', p.astype(v.dtype), vb)
    return o.reshape(B, T, ATT_WIDTH)


def hybrid_layer(x, g_pre, w_in, mu_shift, w0, w_decay_up, a0, w_iclr_up, k_k, k_a, r_k,
                 gn_w, gn_b, b_qkv, sinks, w_branch_rwkv, w_branch_att, w_out):
    h = rms_norm(x, g_pre)
    p = jnp.einsum('btd,dc->btc', h, w_in)
    shifted, g_rwkv, qkv, g_att, gates = _split(
        p, (SHIFT_WIDTH, RWKV_WIDTH, QKV_WIDTH, ATT_WIDTH, N_BRANCHES * D_MODEL))
    shifted = token_shift(shifted, mu_shift)
    r, k, v, w_lo, a_lo = _split(shifted, (RWKV_WIDTH, RWKV_WIDTH, RWKV_WIDTH, DECAY_RANK, ICLR_RANK))
    y_rwkv = rwkv7_time_mix(r, k, v, w_lo, a_lo, w0, w_decay_up, a0, w_iclr_up,
                            k_k, k_a, r_k, gn_w, gn_b)
    q, k_att, v_att = _split(qkv + b_qkv, (ATT_WIDTH, ATT_KV_WIDTH, ATT_KV_WIDTH))
    y_att = sliding_window_sink_attention(q, k_att, v_att, sinks)
    br_rwkv = (y_rwkv * jax.nn.silu(g_rwkv)) @ w_branch_rwkv
    br_att = (y_att * jax.nn.silu(g_att)) @ w_branch_att
    gate_rwkv, gate_att = _split(jax.nn.sigmoid(gates), (D_MODEL, D_MODEL))
    merged = gate_rwkv * br_rwkv + gate_att * br_att
    return x + merged @ w_out


def setup_inputs(seed: int = 0) -> dict:
    key = jax.random.key(seed)
    ks = jax.random.split(key, 20)
    L = DEPTH
    f32 = jnp.float32
    nrm = lambda k, shape, scale: jax.random.normal(k, shape, f32) * scale
    return {
        'x': nrm(ks[0], (BATCH, SEQ, D_MODEL), 1.0),
        'g_pre': 1.0 + nrm(ks[1], (L, D_MODEL), 0.05),
        'w_in': nrm(ks[2], (L, D_MODEL, IN_COLS), D_MODEL ** -0.5),
        'mu_shift': jax.random.uniform(ks[3], (L, SHIFT_WIDTH), f32, 0.1, 0.9),
        'w0': jax.random.uniform(ks[4], (L, RWKV_WIDTH), f32, -6.0, 1.0),
        'w_decay_up': nrm(ks[5], (L, DECAY_RANK, RWKV_WIDTH), 0.5 * DECAY_RANK ** -0.5),
        'a0': nrm(ks[6], (L, RWKV_WIDTH), 0.5),
        'w_iclr_up': nrm(ks[7], (L, ICLR_RANK, RWKV_WIDTH), 0.5 * ICLR_RANK ** -0.5),
        'k_k': 0.85 + nrm(ks[8], (L, RWKV_WIDTH), 0.05),
        'k_a': 1.0 + nrm(ks[9], (L, RWKV_WIDTH), 0.05),
        'r_k': nrm(ks[10], (L, RWKV_WIDTH), 0.1),
        'gn_w': 1.0 + nrm(ks[11], (L, RWKV_WIDTH), 0.05),
        'gn_b': nrm(ks[12], (L, RWKV_WIDTH), 0.02),
        'b_qkv': nrm(ks[13], (L, QKV_WIDTH), 0.02),
        'sinks': nrm(ks[14], (L, ATT_Q_HEADS), 1.0),
        'w_branch_rwkv': nrm(ks[15], (L, RWKV_WIDTH, D_MODEL), RWKV_WIDTH ** -0.5),
        'w_branch_att': nrm(ks[16], (L, ATT_WIDTH, D_MODEL), ATT_WIDTH ** -0.5),
        'w_out': nrm(ks[17], (L, D_MODEL, D_MODEL), D_MODEL ** -0.5),
        'g_final': 1.0 + nrm(ks[18], (D_MODEL,), 0.05),
    }


def reference(x, g_pre, w_in, mu_shift, w0, w_decay_up, a0, w_iclr_up, k_k, k_a, r_k,
              gn_w, gn_b, b_qkv, sinks, w_branch_rwkv, w_branch_att, w_out, g_final):
    for l in range(DEPTH):
        x = hybrid_layer(x, g_pre[l], w_in[l], mu_shift[l], w0[l], w_decay_up[l], a0[l],
                         w_iclr_up[l], k_k[l], k_a[l], r_k[l], gn_w[l], gn_b[l], b_qkv[l],
                         sinks[l], w_branch_rwkv[l], w_branch_att[l], w_out[l])
    return rms_norm(x, g_final)
```

```cpp
#include <hip/hip_runtime.h>
#include <hip/hip_cooperative_groups.h>
#include <cstdio>
#include <cstdint>
namespace cg = cooperative_groups;
namespace pg8 {
#define PG8_LAS __attribute__((address_space(3)))
typedef unsigned short bf16_t;
typedef short bf16x8 __attribute__((ext_vector_type(8)));
typedef float f32x4 __attribute__((ext_vector_type(4)));
typedef unsigned u32x4 __attribute__((ext_vector_type(4)));
constexpr int BM = 256, BK = 64, HALF = 128, HTB = HALF * BK * 2  , STAGE_BYTES = 8 * HTB, NXCD = 8, WGM = 8;

__host__ __device__ __forceinline__ int lds_byte(int r, int c) { const int st = (r >> 4) * 2 + (c >> 5), rr = r & 15, cc = c & 31, ob = rr * 64 + cc * 2; return st * 1024 + (ob ^ (((ob >> 9) & 1) << 5)); }
__host__ __device__ __forceinline__ void stage_rc(int b, int& R, int& C) { const int st = b / 1024, sb = b % 1024, swz = sb ^ (((sb >> 9) & 1) << 5); R = (st >> 1) * 16 + swz / 64; C = (st & 1) * 32 + (swz % 64) / 2; }
__host__ __device__ __forceinline__ int perm32(int rho) { const int n = rho >> 4, i = rho & 15; return 8 * (i >> 2) + 4 * n + (i & 3); }

struct Unit { int pm, pn, kh; };
struct Gemm { const bf16_t* A; const bf16_t* Bt; int M, N, K, lda, ldb; };

struct StaticOrder {
    int nM, nN, nwg, G, c;
    __host__ __device__ void init(int M, int N, int G_, int c_) { nM = M / BM; nN = N / BM; nwg = nM * nN; G = G_; c = c_; }
    __host__ __device__ bool next(int i, Unit& u) const {
        const long L = (long)i * G + c; if (L >= nwg) return false;
        int wgid = (int)L; { const int q = nwg / NXCD, r = nwg % NXCD, xcd = wgid % NXCD, off = wgid / NXCD; wgid = (xcd < r ? xcd * (q + 1) : r * (q + 1) + (xcd - r) * q) + off; }
        const int nig = WGM * nN, gid = wgid / nig, fm = gid * WGM, gsz = (nM - fm) < WGM ? (nM - fm) : WGM;
        u.pm = fm + ((wgid % nig) % gsz); u.pn = (wgid % nig) / gsz; u.kh = 0; return true;
    }
    __device__ __forceinline__ void a_ready(const Unit&) const {}
    __device__ __forceinline__ void done(const Unit&) const {}
};

__device__ __forceinline__ unsigned cvt_pk_bf16(float lo, float hi) { unsigned r; asm volatile("v_cvt_pk_bf16_f32 %0, %1, %2" : "=v"(r) : "v"(lo), "v"(hi)); return r; }
typedef float f32x2 __attribute__((ext_vector_type(2)));
struct StaticOrderRev {
    StaticOrder so;
    __host__ __device__ void init(int M, int N, int G_, int c_) { so.init(M, N, G_, c_); }
    __host__ __device__ bool next(int i, Unit& u) const { if (!so.next(i, u)) return false; u.pn = so.nN - 1 - u.pn; return true; }
    __device__ __forceinline__ void a_ready(const Unit&) const {}
    __device__ __forceinline__ void done(const Unit&) const {}
};
struct StaticOrderK2 {
    StaticOrder so;
    __host__ __device__ void init(int M, int N, int G_, int c_) { so.init(M, N, G_, c_); }
    __host__ __device__ bool next(int i, Unit& u) const { if (!so.next(i >> 1, u)) return false; u.kh = i & 1; return true; }
    __device__ __forceinline__ void a_ready(const Unit&) const {}
    __device__ __forceinline__ void done(const Unit&) const {}
};
template <class Epi, class Sched, bool ALIGN_EPI = false, bool SP2 = false>
__device__ __forceinline__ void gemm_phase(PG8_LAS unsigned char* lds, const Gemm g, const Sched& S, const Epi& E) {
    const int tid = threadIdx.x, wid = __builtin_amdgcn_readfirstlane(tid >> 6), lane = tid & 63, wr = wid >> 2, wc = wid & 3, fr = lane & 15, fq = lane >> 4;
    const int K = g.K, nt = K / BK;
    unsigned voffA[2], voffB[2];
#pragma unroll
    for (int i = 0; i < 2; ++i) { int R, C; stage_rc(tid * 16 + i * 8192, R, C); const int Rb = Epi::PERM ? ((R & ~31) + perm32(R & 31)) : R;
        voffA[i] = (unsigned)(R * g.lda + C) * 2u; voffB[i] = (unsigned)(Rb * g.ldb + C) * 2u; }
    const size_t kstep = (size_t)(BK * 2);
    const size_t hstepA = (size_t)HALF * g.lda * 2, hstepB = (size_t)HALF * g.ldb * 2;
    const size_t tstepA = 2 * hstepA, tstepB = 2 * hstepB;
    const unsigned ldsw = (unsigned)wid * 1024u;
    const int aoff = lds_byte(wr * 64 + fr, fq * 8), boff = lds_byte(wc * 32 + fr, fq * 8);
#define PG8_SA(b, h) (((b) * 2 + (h)) * HTB)
#define PG8_SB(b, h) ((4 + (b) * 2 + (h)) * HTB)
#define PG8_STAGE(bufoff, gbase, voff) do { _Pragma("unroll") for (int _i = 0; _i < 2; ++_i) \
        __builtin_amdgcn_global_load_lds((const unsigned*)((const char*)(gbase) + (voff)[_i]), (PG8_LAS unsigned*)(lds + (bufoff) + ldsw + _i * 8192), 16, 0, 0); } while (0)
#define PG8_LDA(dst, b, h) do { _Pragma("unroll") for (int m = 0; m < 4; ++m) _Pragma("unroll") for (int k = 0; k < 2; ++k) dst[m][k] = *(const PG8_LAS bf16x8*)(lds + PG8_SA(b, h) + aoff + m * 2048 + k * 1024); } while (0)
#define PG8_LDB(dst, b, h) do { _Pragma("unroll") for (int n = 0; n < 2; ++n) _Pragma("unroll") for (int k = 0; k < 2; ++k) dst[n][k] = *(const PG8_LAS bf16x8*)(lds + PG8_SB(b, h) + boff + n * 2048 + k * 1024); } while (0)
#define PG8_MMA(ai, bj, At, Bt) do { __builtin_amdgcn_s_setprio(1); _Pragma("unroll") for (int m = 0; m < 4; ++m) _Pragma("unroll") for (int n = 0; n < 2; ++n) _Pragma("unroll") for (int k = 0; k < 2; ++k) \
        acc[ai][bj][m][n] = __builtin_amdgcn_mfma_f32_16x16x32_bf16(Bt[n][k], At[m][k], acc[ai][bj][m][n], 0, 0, 0); __builtin_amdgcn_s_setprio(0); } while (0)
#define PG8_WAIT_V(n) asm volatile("s_waitcnt vmcnt(" #n ")" ::: "memory")
#define PG8_WAIT_L(n) asm volatile("s_waitcnt lgkmcnt(" #n ")" ::: "memory")
#define PG8_BAR __builtin_amdgcn_s_barrier()
#define PG8_SCHED __builtin_amdgcn_sched_barrier(0)
    Unit cur, nxt; int ui = 0;
    if (!S.next(0, cur)) return;
    f32x4 acc[2][2][4][2];
#pragma unroll
    for (int a = 0; a < 2; ++a)
#pragma unroll
        for (int b = 0; b < 2; ++b)
#pragma unroll
            for (int m = 0; m < 4; ++m)
#pragma unroll
                for (int n = 0; n < 2; ++n) acc[a][b][m][n] = (f32x4){0.f, 0.f, 0.f, 0.f};
    bf16x8 At[4][2], B0[2][2], B1[2][2];
    const char* cA = (const char*)g.A + (size_t)cur.pm * tstepA + (size_t)cur.kh * K * 2; const char* cB = (const char*)g.Bt + (size_t)cur.pn * tstepB + (size_t)cur.kh * K * 2;
    S.a_ready(cur);
    if constexpr (SP2) {
        PG8_STAGE(PG8_SB(0, 0), cB, voffB); PG8_STAGE(PG8_SB(0, 1), cB + hstepB, voffB); PG8_STAGE(PG8_SA(0, 0), cA, voffA); PG8_STAGE(PG8_SA(0, 1), cA + hstepA, voffA);
        if (wr == 1) PG8_BAR;
        PG8_WAIT_V(2); PG8_BAR;
        PG8_STAGE(PG8_SB(1, 0), cB + kstep, voffB); PG8_STAGE(PG8_SA(1, 0), cA + kstep, voffA); PG8_STAGE(PG8_SB(1, 1), cB + hstepB + kstep, voffB);
        PG8_WAIT_V(6); PG8_BAR;
    } else {
        PG8_STAGE(PG8_SB(0, 0), cB, voffB); PG8_STAGE(PG8_SA(0, 0), cA, voffA); PG8_STAGE(PG8_SB(0, 1), cB + hstepB, voffB); PG8_STAGE(PG8_SA(0, 1), cA + hstepA, voffA);
        if (wr == 1) PG8_BAR;
        PG8_WAIT_V(4); PG8_BAR;
        PG8_STAGE(PG8_SB(1, 0), cB + kstep, voffB); PG8_STAGE(PG8_SA(1, 0), cA + kstep, voffA); PG8_STAGE(PG8_SB(1, 1), cB + hstepB + kstep, voffB);
        PG8_WAIT_V(6); PG8_BAR;
    }
    for (;;) {
        const bool has_next = S.next(ui + 1, nxt);
        const char* nA = has_next ? (const char*)g.A + (size_t)nxt.pm * tstepA + (size_t)nxt.kh * K * 2 : cA; const char* nB = has_next ? (const char*)g.Bt + (size_t)nxt.pn * tstepB + (size_t)nxt.kh * K * 2 : cB;
        for (int t = 0; t < nt; t += 2) {
            const bool last = (t == nt - 2);
            const char* a1 = cA + (size_t)(t + 1) * kstep;
            const char* a2 = last ? nA : cA + (size_t)(t + 2) * kstep; const char* b2 = last ? nB : cB + (size_t)(t + 2) * kstep;
            const char* a3 = a2 + kstep; const char* b3 = b2 + kstep;
            if (last && has_next) S.a_ready(nxt);
            if constexpr (SP2) {
            PG8_LDB(B0, 0, 0); PG8_LDB(B1, 0, 1); PG8_SCHED; PG8_LDA(At, 0, 0); PG8_STAGE(PG8_SA(1, 1), a1 + hstepA, voffA);
            PG8_WAIT_V(8); PG8_WAIT_L(0); PG8_BAR; PG8_MMA(0, 0, At, B0); PG8_MMA(0, 1, At, B1); PG8_BAR; PG8_SCHED;
            PG8_LDA(At, 0, 1); PG8_STAGE(PG8_SB(0, 0), b2, voffB); PG8_STAGE(PG8_SB(0, 1), b2 + hstepB, voffB); PG8_STAGE(PG8_SA(0, 0), a2, voffA);
            PG8_WAIT_V(8); PG8_WAIT_L(0); PG8_BAR; PG8_MMA(1, 0, At, B0); PG8_MMA(1, 1, At, B1); PG8_BAR; PG8_SCHED;
            PG8_LDB(B0, 1, 0); PG8_LDB(B1, 1, 1); PG8_SCHED; PG8_LDA(At, 1, 0); PG8_STAGE(PG8_SA(0, 1), a2 + hstepA, voffA);
            PG8_WAIT_V(8); PG8_WAIT_L(0); PG8_BAR; PG8_MMA(0, 0, At, B0); PG8_MMA(0, 1, At, B1); PG8_BAR; PG8_SCHED;
            PG8_LDA(At, 1, 1); PG8_STAGE(PG8_SB(1, 0), b3, voffB); PG8_STAGE(PG8_SB(1, 1), b3 + hstepB, voffB); PG8_STAGE(PG8_SA(1, 0), a3, voffA);
            PG8_WAIT_V(8); PG8_WAIT_L(0); PG8_BAR; PG8_MMA(1, 0, At, B0); PG8_MMA(1, 1, At, B1); PG8_BAR; PG8_SCHED;
            } else {
            PG8_LDB(B0, 0, 0); PG8_SCHED; PG8_LDA(At, 0, 0); PG8_STAGE(PG8_SA(1, 1), a1 + hstepA, voffA);
            PG8_WAIT_L(8); PG8_BAR; PG8_WAIT_L(0); PG8_MMA(0, 0, At, B0); PG8_BAR; PG8_SCHED;
            PG8_LDB(B1, 0, 1); PG8_STAGE(PG8_SB(0, 0), b2, voffB);
            PG8_BAR; PG8_WAIT_L(0); PG8_MMA(0, 1, At, B1); PG8_BAR;
            PG8_LDA(At, 0, 1); PG8_STAGE(PG8_SA(0, 0), a2, voffA);
            PG8_BAR; PG8_WAIT_L(0); PG8_MMA(1, 0, At, B0); PG8_BAR; PG8_SCHED;
            PG8_STAGE(PG8_SB(0, 1), b2 + hstepB, voffB);
            PG8_WAIT_V(6); PG8_BAR; PG8_MMA(1, 1, At, B1); PG8_BAR;
            PG8_LDB(B0, 1, 0); PG8_SCHED; PG8_LDA(At, 1, 0); PG8_STAGE(PG8_SA(0, 1), a2 + hstepA, voffA);
            PG8_WAIT_L(8); PG8_BAR; PG8_WAIT_L(0); PG8_MMA(0, 0, At, B0); PG8_BAR; PG8_SCHED;
            PG8_LDB(B1, 1, 1); PG8_STAGE(PG8_SB(1, 0), b3, voffB);
            PG8_BAR; PG8_WAIT_L(0); PG8_MMA(0, 1, At, B1); PG8_BAR;
            PG8_LDA(At, 1, 1); PG8_STAGE(PG8_SA(1, 0), a3, voffA);
            PG8_BAR; PG8_WAIT_L(0); PG8_MMA(1, 0, At, B0); PG8_BAR; PG8_SCHED;
            PG8_STAGE(PG8_SB(1, 1), b3 + hstepB, voffB);
            PG8_WAIT_V(6); PG8_BAR; PG8_MMA(1, 1, At, B1); PG8_BAR;
            }
        }
        if constexpr (ALIGN_EPI) { if (wr == 0) PG8_BAR; }
        if constexpr (!Epi::AFTER_DRAIN) { E(acc, cur, wr, wc, fr, fq); S.done(cur); }
        if (!has_next) break;
        if (!(Epi::KEEP && cur.kh == 0)) {
#pragma unroll
        for (int a = 0; a < 2; ++a)
#pragma unroll
            for (int b = 0; b < 2; ++b)
#pragma unroll
                for (int m = 0; m < 4; ++m)
#pragma unroll
                    for (int n = 0; n < 2; ++n) acc[a][b][m][n] = (f32x4){0.f, 0.f, 0.f, 0.f};
        }
        cur = nxt; cA = nA; cB = nB; ++ui;
        if constexpr (ALIGN_EPI) { if (wr == 1) PG8_BAR; }
    }
    PG8_WAIT_V(0);
    if constexpr (!ALIGN_EPI) { if (wr == 0) PG8_BAR; }
    PG8_BAR;
    if constexpr (Epi::AFTER_DRAIN) { E.fused(acc, cur, wr, wc, fr, fq, lds, wid, lane); S.done(cur); }
#undef PG8_SA
#undef PG8_SB
#undef PG8_STAGE
#undef PG8_LDA
#undef PG8_LDB
#undef PG8_MMA
#undef PG8_WAIT_V
#undef PG8_WAIT_L
#undef PG8_BAR
#undef PG8_SCHED
}
}

#define GAS __attribute__((address_space(1)))
#define LAS __attribute__((address_space(3)))
typedef unsigned short bf16;
typedef unsigned u32x4 __attribute__((ext_vector_type(4)));
typedef unsigned u32x2 __attribute__((ext_vector_type(2)));
typedef float f32x4 __attribute__((ext_vector_type(4)));
typedef float f32x16 __attribute__((ext_vector_type(16)));
typedef short bf16x8 __attribute__((ext_vector_type(8)));
typedef short s16x4 __attribute__((ext_vector_type(4)));

constexpr int NT = 512;
constexpr int BATCH = 2, SEQ = 8192, DM = 1024, M = BATCH * SEQ;
constexpr int NH = 8, HD = 64, RW = 512;
constexpr int SHW = 1664, INC = 5504, INCP = 5632;
constexpr int QKVW = 768;
constexpr int NCHUNK = SEQ / 64;
constexpr size_t MiB = 1u << 20;
constexpr size_t WS_ROWSS = 0;
constexpr size_t WS_BAR = 1024 * 1024;
constexpr size_t WS_PCNT = 1280 * 1024;
constexpr size_t WS_DUMMY = 1536 * 1024;
constexpr size_t WS_CT = 256 * 1024;
constexpr size_t WS_WBR = 2 * MiB, WS_WOUT = 4 * MiB, WS_WIN = 6 * MiB;
constexpr size_t WS_HB = 17 * MiB;
constexpr size_t WS_SH = 49 * MiB;
constexpr size_t WS_G = 101 * MiB;
constexpr size_t WS_QKV = 133 * MiB;
constexpr size_t WS_PS = 157 * MiB;
constexpr size_t WS_SL = 189 * MiB;
constexpr size_t WS_PY = 221 * MiB;
constexpr size_t WS_YL = 6 * MiB;
constexpr size_t WS_MG = WS_PS;
constexpr int LDS_BYTES = 147456;

struct Args {
    const float* in[19]; float* out; unsigned char* ws; int ph_lo, ph_hi, use_xb, dry;
};
enum { I_X = 0, I_GPRE, I_WIN, I_MU, I_W0, I_WDU, I_A0, I_WIU, I_KK, I_KA, I_RK, I_GNW, I_GNB, I_BQKV, I_SINKS, I_WBR, I_WBA, I_WOUT, I_GFIN };

typedef float f32x2_t __attribute__((ext_vector_type(2)));
typedef __bf16 bf16x2_t __attribute__((ext_vector_type(2)));
__device__ __forceinline__ unsigned pk2(float lo, float hi) { const f32x2_t v = {lo, hi}; const bf16x2_t b = __builtin_convertvector(v, bf16x2_t); return __builtin_bit_cast(unsigned, b); }
__device__ __forceinline__ unsigned f2bf(float f) { return pk2(f, 0.f) & 0xffffu; }
__device__ __forceinline__ float bf2f(unsigned short b) { return __builtin_bit_cast(float, (unsigned)b << 16); }
__device__ __forceinline__ float bflo(unsigned w) { return __builtin_bit_cast(float, w << 16); }
__device__ __forceinline__ float bfhi(unsigned w) { return __builtin_bit_cast(float, w & 0xffff0000u); }
__device__ __forceinline__ float dppx(float x, const int sel) {
    const int v = __builtin_bit_cast(int, x); int r;
    if (sel == 0) r = __builtin_amdgcn_update_dpp(0, v, 0xB1, 0xF, 0xF, true);
    else if (sel == 1) r = __builtin_amdgcn_update_dpp(0, v, 0x4E, 0xF, 0xF, true);
    else if (sel == 2) r = __builtin_amdgcn_update_dpp(0, v, 0x141, 0xF, 0xF, true);
    else r = __builtin_amdgcn_update_dpp(0, v, 0x140, 0xF, 0xF, true);
    return __builtin_bit_cast(float, r);
}
__device__ __forceinline__ float wave_sum(float v) {
    v += dppx(v, 0); v += dppx(v, 1); v += dppx(v, 2); v += dppx(v, 3);
    const int iv = __builtin_bit_cast(int, v);
    const float r0 = __builtin_bit_cast(float, __builtin_amdgcn_readlane(iv, 0)), r1 = __builtin_bit_cast(float, __builtin_amdgcn_readlane(iv, 16));
    const float r2 = __builtin_bit_cast(float, __builtin_amdgcn_readlane(iv, 32)), r3 = __builtin_bit_cast(float, __builtin_amdgcn_readlane(iv, 48));
    return (r0 + r1) + (r2 + r3);
}
__device__ __forceinline__ float sigmoidf_(float x) { return __builtin_amdgcn_rcpf(1.f + __expf(-x)); }
__device__ __forceinline__ float siluf_(float x) { return x * __builtin_amdgcn_rcpf(1.f + __expf(-x)); }

namespace pg8 {
struct EpiIn {
    static constexpr bool PERM = true, AFTER_DRAIN = false, MID = false, KEEP = false;
    bf16_t *SH, *G, *QKV, *GT; const float* bqkv;
    __device__ __forceinline__ void operator()(const f32x4 (&acc)[2][2][4][2], const Unit& u, int wr, int wc, int fr, int fq) const {
        const int row0 = u.pm * BM + wr * 64 + fr;
#pragma unroll
        for (int bj = 0; bj < 2; ++bj) {
            const int c128 = u.pn * 2 + bj;
            if (c128 >= 43) continue;
            const int col = c128 * 128 + wc * 32 + 8 * fq;
            int kind, ld, dcol; bf16_t* base;
            if (c128 < 13) { kind = 0; base = SH; ld = 1664; dcol = col; }
            else if (c128 < 17) { kind = 1; base = G; ld = 1024; dcol = col - 1664; }
            else if (c128 < 23) { kind = 2; base = QKV; ld = 768; dcol = col - 2176; }
            else if (c128 < 27) { kind = 1; base = G; ld = 1024; dcol = col - 2944 + 512; }
            else { kind = 3; base = GT; ld = 2048; dcol = col - 3456; }
            f32x4 b0 = {0.f, 0.f, 0.f, 0.f}, b1 = {0.f, 0.f, 0.f, 0.f}; float sc = 1.f;
            if (kind == 2) { b0 = *(const f32x4*)(bqkv + dcol); b1 = *(const f32x4*)(bqkv + dcol + 4); sc = dcol < 512 ? 0.125f : 1.f; }
#pragma unroll
            for (int ai = 0; ai < 2; ++ai)
#pragma unroll
                for (int m = 0; m < 4; ++m) {
                    f32x4 v0 = acc[ai][bj][m][0], v1 = acc[ai][bj][m][1];
                    if (kind == 1) {
#pragma unroll
                        for (int e = 0; e < 4; ++e) { v0[e] = v0[e] * sigmoidf_(v0[e]); v1[e] = v1[e] * sigmoidf_(v1[e]); }
                    } else if (kind == 2) { v0 = (v0 + b0) * sc; v1 = (v1 + b1) * sc; }
                    else if (kind == 3) {
#pragma unroll
                        for (int e = 0; e < 4; ++e) { v0[e] = sigmoidf_(v0[e]); v1[e] = sigmoidf_(v1[e]); }
                    }
                    if (kind == 3) {
                        u32x2 w8 = {0u, 0u};
#pragma unroll
                        for (int e = 0; e < 4; ++e) { w8.x = __builtin_amdgcn_cvt_pk_u8_f32(fmaxf(v0[e] * 255.f, 1.f), e, w8.x); w8.y = __builtin_amdgcn_cvt_pk_u8_f32(fmaxf(v1[e] * 255.f, 1.f), e, w8.y); }
                        *(u32x2*)((unsigned char*)GT + (size_t)(row0 + ai * HALF + m * 16) * 2048 + dcol) = w8;
                    } else {
                    u32x4 w; w.x = cvt_pk_bf16(v0[0], v0[1]); w.y = cvt_pk_bf16(v0[2], v0[3]); w.z = cvt_pk_bf16(v1[0], v1[1]); w.w = cvt_pk_bf16(v1[2], v1[3]);
                    *(u32x4*)(base + (size_t)(row0 + ai * HALF + m * 16) * ld + dcol) = w;
                    }
                }
        }
    }
};
struct EpiMerge {
    static constexpr bool PERM = true, AFTER_DRAIN = false, MID = false, KEEP = true;
    const unsigned char* GT; bf16_t* MG;
    __device__ __forceinline__ void operator()(f32x4 (&acc)[2][2][4][2], const Unit& u, int wr, int wc, int fr, int fq) const {
        const int row0 = u.pm * BM + wr * 64 + fr;
        if (u.kh == 0) {
#pragma unroll
            for (int ai = 0; ai < 2; ++ai)
#pragma unroll
                for (int m = 0; m < 4; ++m)
#pragma unroll
                    for (int bj = 0; bj < 2; ++bj) {
                        const unsigned char* gp = GT + (size_t)(row0 + ai * HALF + m * 16) * 2048 + u.pn * BM + bj * HALF + wc * 32 + 8 * fq;
                        const u32x2 gr = *(const u32x2*)gp, ga = *(const u32x2*)(gp + 1024);
#pragma unroll
                        for (int e = 0; e < 8; ++e) {
                            const float r_ = (float)(((e < 4 ? gr.x : gr.y) >> (8 * (e & 3))) & 0xffu), a_ = (float)(((e < 4 ? ga.x : ga.y) >> (8 * (e & 3))) & 0xffu);
                            acc[ai][bj][m][e >> 2][e & 3] *= r_ * __builtin_amdgcn_rcpf(a_);
                        }
                    }
        } else {
#pragma unroll
            for (int ai = 0; ai < 2; ++ai)
#pragma unroll
                for (int m = 0; m < 4; ++m)
#pragma unroll
                    for (int bj = 0; bj < 2; ++bj) {
                        const size_t r = (size_t)(row0 + ai * HALF + m * 16); const int c0 = u.pn * BM + bj * HALF + wc * 32 + 8 * fq;
                        const u32x2 ga = *(const u32x2*)(GT + r * 2048 + 1024 + c0);
                        float o[8];
#pragma unroll
                        for (int e = 0; e < 8; ++e) o[e] = acc[ai][bj][m][e >> 2][e & 3] * ((float)(((e < 4 ? ga.x : ga.y) >> (8 * (e & 3))) & 0xffu) * (1.f / 255.f));
                        u32x4 w; w.x = cvt_pk_bf16(o[0], o[1]); w.y = cvt_pk_bf16(o[2], o[3]); w.z = cvt_pk_bf16(o[4], o[5]); w.w = cvt_pk_bf16(o[6], o[7]);
                        *(u32x4*)(MG + r * 1024 + c0) = w;
                    }
        }
    }
};
struct EpiOutNorm {
    static constexpr bool PERM = false, AFTER_DRAIN = true, MID = false, KEEP = false;
    const float* x; float* out; float* rowss; unsigned* cnt; const float* gfin;
    __device__ __forceinline__ void fused(f32x4 (&acc)[2][2][4][2], const Unit& u, int wr, int wc, int fr, int fq, PG8_LAS unsigned char* lds, int wid, int lane) const {
#pragma unroll
        for (int ai = 0; ai < 2; ++ai)
#pragma unroll
            for (int m = 0; m < 4; ++m) {
                const int r = u.pm * BM + ai * HALF + wr * 64 + m * 16 + fr; float ss = 0.f;
#pragma unroll
                for (int bj = 0; bj < 2; ++bj)
#pragma unroll
                    for (int n = 0; n < 2; ++n) {
                        const size_t off = (size_t)r * 1024 + u.pn * BM + bj * HALF + wc * 32 + n * 16 + 4 * fq;
                        const f32x4 o = *(const f32x4*)(x + off) + acc[ai][bj][m][n];
                        acc[ai][bj][m][n] = o; ss += (o[0] * o[0] + o[1] * o[1]) + (o[2] * o[2] + o[3] * o[3]);
                    }
                ss += __shfl_xor(ss, 16); ss += __shfl_xor(ss, 32);
                if (fq == 0) atomicAdd(rowss + r, ss);
                if (m == 3) asm volatile("" ::: "memory");
            }
        asm volatile("s_waitcnt vmcnt(0)" ::: "memory");
        __syncthreads();
        if (threadIdx.x == 0) {
            __hip_atomic_fetch_add(cnt + 64 * u.pm, 1u, __ATOMIC_RELEASE, __HIP_MEMORY_SCOPE_AGENT);
            unsigned spins = 0;
            while (__hip_atomic_load(cnt + 64 * u.pm, __ATOMIC_ACQUIRE, __HIP_MEMORY_SCOPE_AGENT) < 4u) { __builtin_amdgcn_s_sleep(2); if (++spins > (1u << 22)) break; }
        }
        __syncthreads();
#pragma unroll
        for (int ai = 0; ai < 2; ++ai)
#pragma unroll
            for (int m = 0; m < 4; ++m) {
                const int r = u.pm * BM + ai * HALF + wr * 64 + m * 16 + fr;
                const float sc = 1.f / sqrtf(__hip_atomic_load(rowss + r, __ATOMIC_RELAXED, __HIP_MEMORY_SCOPE_AGENT) * (1.f / 1024.f) + 1e-6f);
#pragma unroll
                for (int bj = 0; bj < 2; ++bj)
#pragma unroll
                    for (int n = 0; n < 2; ++n) {
                        const int col = u.pn * BM + bj * HALF + wc * 32 + n * 16 + 4 * fq;
                        *(f32x4*)(out + (size_t)r * 1024 + col) = acc[ai][bj][m][n] * sc * *(const f32x4*)(gfin + col);
                    }
            }
    }
};
}

__device__ __forceinline__ void p0_transpose_item(const float* W, int N, bf16* WT, int ldo, int koff, LAS float* scr, int item, int lane) {
    const int nblk = N / 32, kb = item / nblk, nb = item % nblk, k0 = 64 * kb, n0 = 32 * nb;
    float wv[32];
#pragma unroll
    for (int i = 0; i < 32; ++i) wv[i] = W[(size_t)(k0 + 2 * i + (lane >> 5)) * N + n0 + (lane & 31)];
#pragma unroll
    for (int i = 0; i < 32; ++i) scr[(2 * i + (lane >> 5)) * 33 + (lane & 31)] = wv[i];
    asm volatile("s_waitcnt lgkmcnt(0)" ::: "memory");
    const int c = lane & 7;
#pragma unroll
    for (int j = 0; j < 4; ++j) { const int n = (lane >> 3) + 8 * j; const LAS float* s = scr + (8 * c) * 33 + n;
        u32x4 o; o.x = pk2(s[0 * 33], s[1 * 33]); o.y = pk2(s[2 * 33], s[3 * 33]); o.z = pk2(s[4 * 33], s[5 * 33]); o.w = pk2(s[6 * 33], s[7 * 33]);
        *(u32x4*)(WT + (size_t)(n0 + n) * ldo + koff + k0 + 8 * c) = o; }
    asm volatile("s_waitcnt lgkmcnt(0)" ::: "memory");
}
__device__ __forceinline__ void p0_prologue(const Args& a, LAS unsigned char* lds, int tid, int wave, int lane) {
    unsigned char* ws = a.ws;
    LAS float* scr = (LAS float*)(lds + wave * 16384);
    const int gw = blockIdx.x * 8 + wave, NGW = gridDim.x * 8;
    constexpr int I_IN = (DM / 64) * (INC / 32), I_BR = (RW / 64) * (DM / 32), I_O = (DM / 64) * (DM / 32);
    constexpr int NITEMS = I_IN + 2 * I_BR + I_O;
    for (int it = gw; it < NITEMS; it += NGW) {
        int r = it;
        if (r < I_IN) { p0_transpose_item(a.in[I_WIN], INC, (bf16*)(ws + WS_WIN), DM, 0, scr, r, lane); continue; } r -= I_IN;
        if (r < I_BR) { p0_transpose_item(a.in[I_WBR], DM, (bf16*)(ws + WS_WBR), DM, 0, scr, r, lane); continue; } r -= I_BR;
        if (r < I_BR) { p0_transpose_item(a.in[I_WBA], DM, (bf16*)(ws + WS_WBR), DM, RW, scr, r, lane); continue; } r -= I_BR;
        p0_transpose_item(a.in[I_WOUT], DM, (bf16*)(ws + WS_WOUT), DM, 0, scr, r, lane);
    }
    { const int gt = blockIdx.x * NT + tid, GT_ = gridDim.x * NT;
      u32x4* wp = (u32x4*)((bf16*)(ws + WS_WIN) + (size_t)INC * DM);
      for (int i = gt; i < (INCP - INC) * DM / 8; i += GT_) wp[i] = (u32x4){0u, 0u, 0u, 0u};
      float* rs = (float*)(ws + WS_ROWSS);
      for (int i = gt; i < M; i += GT_) rs[i] = 0.f;
      unsigned* pc = (unsigned*)(ws + WS_PCNT);
      for (int i = gt; i < 64 * 64; i += GT_) pc[i] = 0u; }
    const float* gp = a.in[I_GPRE];
    f32x4 gv[4];
#pragma unroll
    for (int j = 0; j < 4; ++j) gv[j] = ((const f32x4*)gp)[lane + 64 * j];
    for (int m = gw; m < M; m += 2 * NGW) {
        const f32x4* xr0 = (const f32x4*)(a.in[I_X] + (size_t)m * DM) + lane; const f32x4* xr1 = xr0 + (size_t)NGW * (DM / 4);
        f32x4 v0[4], v1[4]; float s0 = 0.f, s1 = 0.f;
#pragma unroll
        for (int j = 0; j < 4; ++j) { v0[j] = xr0[64 * j]; v1[j] = xr1[64 * j]; }
#pragma unroll
        for (int j = 0; j < 4; ++j) { s0 += (v0[j].x * v0[j].x + v0[j].y * v0[j].y) + (v0[j].z * v0[j].z + v0[j].w * v0[j].w); s1 += (v1[j].x * v1[j].x + v1[j].y * v1[j].y) + (v1[j].z * v1[j].z + v1[j].w * v1[j].w); }
        const float sc0 = 1.f / sqrtf(wave_sum(s0) * (1.f / DM) + 1e-6f), sc1 = 1.f / sqrtf(wave_sum(s1) * (1.f / DM) + 1e-6f);
        unsigned long long* o0 = (unsigned long long*)((bf16*)(ws + WS_HB) + (size_t)m * DM) + lane; unsigned long long* o1 = o0 + (size_t)NGW * (DM / 4);
#pragma unroll
        for (int j = 0; j < 4; ++j) { const f32x4 y0 = v0[j] * sc0 * gv[j], y1 = v1[j] * sc1 * gv[j];
            o0[64 * j] = (unsigned long long)pk2(y0.x, y0.y) | ((unsigned long long)pk2(y0.z, y0.w) << 32); o1[64 * j] = (unsigned long long)pk2(y1.x, y1.y) | ((unsigned long long)pk2(y1.z, y1.w) << 32); }
    }
}

__device__ __forceinline__ void attn_item(LAS unsigned char* lds, const Args& a, int b, int qb, int kvh, int tid, int wave, int lane, int dry) {
    LAS bf16* Ks = (LAS bf16*)lds;
    LAS bf16* Vt = (LAS bf16*)(lds + 36864);
    const bf16* QKV = (const bf16*)(a.ws + WS_QKV);
    bf16* G = (bf16*)(a.ws + WS_G);
    const long m0 = (long)b * SEQ + qb * 128;
    const int g = wave >> 1, qh = wave & 1, head = kvh * 4 + g;
    const int r = lane & 31, h = lane >> 5;
    u32x4 kv[4], vv[4];
#pragma unroll
    for (int i = 0; i < 4; ++i) {
        const int c = tid + i * NT, key = c >> 3, d8 = (c & 7) * 8; const long row = m0 - 128 + key;
        kv[i] = (u32x4){0u, 0u, 0u, 0u}; vv[i] = (u32x4){0u, 0u, 0u, 0u};
        if (qb > 0 || key >= 128) { kv[i] = *(const u32x4*)(QKV + row * QKVW + 512 + kvh * 64 + d8); vv[i] = *(const u32x4*)(QKV + row * QKVW + 640 + kvh * 64 + d8); }
    }
    bf16x8 qf[2][4];
#pragma unroll
    for (int s = 0; s < 4; ++s) qf[0][s] = *(const bf16x8*)(QKV + (m0 + qh * 64 + r) * QKVW + head * 64 + 8 * h + 16 * s);
#pragma unroll
    for (int i = 0; i < 4; ++i) {
        const int c = tid + i * NT, key = c >> 3, d8 = (c & 7) * 8;
        *(LAS u32x4*)(Ks + key * 72 + d8) = kv[i];
#pragma unroll
        for (int e = 0; e < 4; ++e) { const unsigned w = e == 0 ? vv[i].x : e == 1 ? vv[i].y : e == 2 ? vv[i].z : vv[i].w; Vt[(d8 + 2 * e) * 264 + key] = (bf16)(w & 0xffffu); Vt[(d8 + 2 * e + 1) * 264 + key] = (bf16)(w >> 16); }
    }
    __syncthreads();
    const float sink = a.in[I_SINKS][head];
#pragma unroll
    for (int qt = 0; qt < 2; ++qt) {
        const int q0 = qh * 64 + qt * 32, kt0 = q0 >> 5, qi = q0 + r;
        bf16* gp = G + (m0 + qi) * 1024 + 512 + head * 64;
        bf16* op = (dry & 1) ? (bf16*)(a.ws + 38 * MiB) + ((m0 + qi) & 4095) * 1024 + 512 + head * 64 : gp;
        u32x2 gt[8];
#pragma unroll
        for (int e = 0; e < 8; ++e) gt[e] = *(const u32x2*)(gp + (e >> 2) * 32 + 8 * (e & 3) + 4 * h);
        if (qt == 0) {
#pragma unroll
            for (int s = 0; s < 4; ++s) qf[1][s] = *(const bf16x8*)(QKV + (m0 + q0 + 32 + r) * QKVW + head * 64 + 8 * h + 16 * s);
        }
        f32x16 X[5];
#pragma unroll
        for (int kk = 0; kk < 5; ++kk) {
            f32x16 acc;
#pragma unroll
            for (int i = 0; i < 16; ++i) acc[i] = 0.f;
            const LAS bf16* kp = Ks + ((kt0 + kk) * 32 + r) * 72 + 8 * h;
#pragma unroll
            for (int s = 0; s < 4; ++s) { const bf16x8 kf = *(const LAS bf16x8*)(kp + 16 * s); acc = __builtin_amdgcn_mfma_f32_32x32x16_bf16(kf, qf[qt][s], acc, 0, 0, 0); }
            X[kk] = acc;
        }
        float mx = sink;
#pragma unroll
        for (int kk = 0; kk < 5; ++kk)
#pragma unroll
            for (int i = 0; i < 16; ++i) {
                const int kj = (kt0 + kk) * 32 + (i & 3) + 8 * (i >> 2) + 4 * h;
                const bool valid = (kj > qi) && (kj <= qi + 128) && (qb > 0 || kj >= 128);
                const float s = valid ? X[kk][i] : -1e30f; X[kk][i] = s; mx = fmaxf(mx, s);
            }
        mx = fmaxf(mx, __shfl_xor(mx, 32));
        float sum = 0.f;
#pragma unroll
        for (int kk = 0; kk < 5; ++kk)
#pragma unroll
            for (int i = 0; i < 16; ++i) { const float p = __expf(X[kk][i] - mx); X[kk][i] = p; sum += p; }
        sum += __shfl_xor(sum, 32); sum += __expf(sink - mx);
        const float inv = 1.f / sum;
        f32x16 O[2];
#pragma unroll
        for (int i = 0; i < 16; ++i) { O[0][i] = 0.f; O[1][i] = 0.f; }
#pragma unroll
        for (int kk = 0; kk < 5; ++kk)
#pragma unroll
            for (int s = 0; s < 2; ++s) {
                u32x4 pw; pw.x = pk2(X[kk][8 * s + 0], X[kk][8 * s + 1]); pw.y = pk2(X[kk][8 * s + 2], X[kk][8 * s + 3]); pw.z = pk2(X[kk][8 * s + 4], X[kk][8 * s + 5]); pw.w = pk2(X[kk][8 * s + 6], X[kk][8 * s + 7]);
                const bf16x8 pf = __builtin_bit_cast(bf16x8, pw);
#pragma unroll
                for (int dt = 0; dt < 2; ++dt) {
                    const LAS bf16* vp = Vt + (dt * 32 + r) * 264 + (kt0 + kk) * 32 + 16 * s + 4 * h;
                    const u32x2 v0 = *(const LAS u32x2*)vp, v1 = *(const LAS u32x2*)(vp + 8);
                    const u32x4 vw = {v0.x, v0.y, v1.x, v1.y};
                    O[dt] = __builtin_amdgcn_mfma_f32_32x32x16_bf16(__builtin_bit_cast(bf16x8, vw), pf, O[dt], 0, 0, 0);
                }
            }
#pragma unroll
        for (int dt = 0; dt < 2; ++dt)
#pragma unroll
            for (int g4 = 0; g4 < 4; ++g4) {
                const int d = dt * 32 + 8 * g4 + 4 * h;
                const u32x2 gv = gt[dt * 4 + g4];
                u32x2 o; o.x = pk2(O[dt][4 * g4 + 0] * inv * bflo(gv.x), O[dt][4 * g4 + 1] * inv * bfhi(gv.x)); o.y = pk2(O[dt][4 * g4 + 2] * inv * bflo(gv.y), O[dt][4 * g4 + 3] * inv * bfhi(gv.y));
                *(u32x2*)(op + d) = o;
            }
    }
    __syncthreads();
}

#define LBAR() asm volatile("s_waitcnt lgkmcnt(0)\n\ts_barrier" ::: "memory")
constexpr int LD = 65, SLOT = 64 * LD;
constexpr int RW_SMALL = 34176;
__device__ __forceinline__ f32x16 zero16() { f32x16 z;
#pragma unroll
    for (int i = 0; i < 16; ++i) z[i] = 0.f;
    return z; }
template <bool AT, bool BT>
__device__ __forceinline__ f32x16 mm32(const LAS float* A, const LAS float* B, int m0, int n0, int lane, f32x16 acc, int kbeg = 0, int kend = 64) {
    const int i = lane & 31, kh = lane >> 5;
#pragma unroll 8
    for (int k = kbeg; k < kend; k += 2) {
        const float av = AT ? A[(k + kh) * LD + m0 + i] : A[(m0 + i) * LD + k + kh];
        const float bv = BT ? B[(n0 + i) * LD + k + kh] : B[(k + kh) * LD + n0 + i];
        acc = __builtin_amdgcn_mfma_f32_32x32x2f32(av, bv, acc, 0, 0, 0);
    }
    return acc;
}
__device__ __forceinline__ int crow(int i, int h) { return (i & 3) + 8 * (i >> 2) + 4 * h; }
__device__ __forceinline__ float dpp_f(float x, const int ctrl_sel) {
    int v = __builtin_bit_cast(int, x), r;
    if (ctrl_sel == 0) r = __builtin_amdgcn_update_dpp(0, v, 0xB1, 0xF, 0xF, true);
    else if (ctrl_sel == 1) r = __builtin_amdgcn_update_dpp(0, v, 0x4E, 0xF, 0xF, true);
    else r = __builtin_amdgcn_update_dpp(0, v, 0x141, 0xF, 0xF, true);
    return __builtin_bit_cast(float, r);
}
__device__ __forceinline__ float sum8(float x) { x += dpp_f(x, 0); x += dpp_f(x, 1); x += dpp_f(x, 2); return x; }

__device__ __forceinline__ f32x16 mmb_fwd(const LAS bf16* A, const LAS bf16* B, int m0, int n0, int lane, f32x16 acc) {
    const LAS bf16* ap = A + (m0 + (lane & 31)) * 72 + 8 * (lane >> 5); const LAS bf16* bp = B + (n0 + (lane & 31)) * 72 + 8 * (lane >> 5);
#pragma unroll
    for (int s = 0; s < 4; ++s) acc = __builtin_amdgcn_mfma_f32_32x32x16_bf16(*(const LAS bf16x8*)(ap + 16 * s), *(const LAS bf16x8*)(bp + 16 * s), acc, 0, 0, 0);
    return acc;
}
struct RWP { u32x4 du_hi, du_lo, iu_hi, iu_lo; float mu_w, mu_a, mu_r, mu_k, mu_v, kkw, kaw, rkw, w0a0; };
__device__ __forceinline__ void rwp_load(RWP& p, const Args& a, int h, int wave, int lane) {
    const int ch = h * 64 + lane; float wdu[8], wiu[8], lo_[8];
#pragma unroll
    for (int tt = 0; tt < 8; ++tt) { const int i = 8 * wave + tt; wdu[tt] = a.in[I_WDU][(size_t)i * RW + ch]; wiu[tt] = a.in[I_WIU][(size_t)i * RW + ch]; }
#pragma unroll
    for (int tt = 0; tt < 8; ++tt) lo_[tt] = wdu[tt] - bf2f((bf16)f2bf(wdu[tt]));
    p.du_hi = (u32x4){pk2(wdu[0], wdu[1]), pk2(wdu[2], wdu[3]), pk2(wdu[4], wdu[5]), pk2(wdu[6], wdu[7])}; p.du_lo = (u32x4){pk2(lo_[0], lo_[1]), pk2(lo_[2], lo_[3]), pk2(lo_[4], lo_[5]), pk2(lo_[6], lo_[7])};
#pragma unroll
    for (int tt = 0; tt < 8; ++tt) lo_[tt] = wiu[tt] - bf2f((bf16)f2bf(wiu[tt]));
    p.w0a0 = a.in[(wave >> 2) ? I_A0 : I_W0][h * 64 + (wave & 1) * 32 + (lane & 31)];
    { const float* mu = a.in[I_MU]; p.mu_w = mu[1536 + lane]; p.mu_a = mu[1600 + lane]; p.mu_r = mu[ch]; p.mu_k = mu[512 + ch]; p.mu_v = mu[1024 + ch]; p.kkw = a.in[I_KK][ch]; p.kaw = a.in[I_KA][ch]; p.rkw = a.in[I_RK][ch]; }
    p.iu_hi = (u32x4){pk2(wiu[0], wiu[1]), pk2(wiu[2], wiu[3]), pk2(wiu[4], wiu[5]), pk2(wiu[6], wiu[7])}; p.iu_lo = (u32x4){pk2(lo_[0], lo_[1]), pk2(lo_[2], lo_[3]), pk2(lo_[4], lo_[5]), pk2(lo_[6], lo_[7])};
}
template <int MODE>
__device__ __forceinline__ void rw_prep(LAS float* X, const Args& a, int b, int h, int t0, int tid, int wave, int lane, int dry, const RWP& pw) {
    const bf16* SH = (const bf16*)(a.ws + WS_SH);
    const float* mu = a.in[I_MU];
    const int j = lane, ch = h * 64 + j;
    const size_t mrow = (size_t)b * SEQ + t0;
    const bf16* sh = SH + (mrow + 8 * wave) * SHW;
    const bool first = (t0 + 8 * wave == 0);
    LAS float* tot = X + RW_SMALL;
    LAS float* ctl = X + RW_SMALL + 512;
    bf16 rw_[9], ra_[9], rr_[9], rk_[9], rv_[9];
#pragma unroll
    for (int tt = 0; tt < 9; ++tt) {
        const bf16* p = sh + (long)(tt - 1) * SHW;
        const bool z = (tt == 0) && first;
        rw_[tt] = z ? (bf16)0 : p[1536 + j]; ra_[tt] = z ? (bf16)0 : p[1600 + j];
        rr_[tt] = z ? (bf16)0 : p[ch]; rk_[tt] = z ? (bf16)0 : p[512 + ch]; rv_[tt] = z ? (bf16)0 : p[1024 + ch];
    }
    const float mu_w = pw.mu_w, mu_a = pw.mu_a, mu_r = pw.mu_r, mu_k = pw.mu_k, mu_v = pw.mu_v;
    const float kkw = pw.kkw, kaw = pw.kaw, rkw = pw.rkw;
    {
        LAS bf16* Bq = (LAS bf16*)X;
#pragma unroll
        for (int tt = 0; tt < 8; ++tt) {
            const int t = 8 * wave + tt;
            const float pw = bf2f(rw_[tt + 1]), pa = bf2f(ra_[tt + 1]), qw = bf2f(rw_[tt]), qa = bf2f(ra_[tt]);
            const float xw = pw + (qw - pw) * mu_w;
            const float e2 = __expf(2.f * xw);
            Bq[0 * 4608 + t * 72 + j] = (bf16)f2bf(1.f - 2.f * __builtin_amdgcn_rcpf(e2 + 1.f));
            Bq[1 * 4608 + t * 72 + j] = (bf16)f2bf(pa + (qa - pa) * mu_a);
        }
        *(LAS u32x4*)(Bq + 2 * 4608 + j * 72 + 8 * wave) = pw.du_hi; *(LAS u32x4*)(Bq + 3 * 4608 + j * 72 + 8 * wave) = pw.du_lo;
        *(LAS u32x4*)(Bq + 4 * 4608 + j * 72 + 8 * wave) = pw.iu_hi; *(LAS u32x4*)(Bq + 5 * 4608 + j * 72 + 8 * wave) = pw.iu_lo;
    }
    LBAR();
    if (dry & 128) return;
    {
        const int hf = wave >> 2, mt = (wave >> 1) & 1, nt = wave & 1;
        LAS bf16* Bq = (LAS bf16*)X;
        f32x16 acc = mmb_fwd(Bq + hf * 4608, Bq + (2 + 2 * hf) * 4608, mt * 32, nt * 32, lane, zero16());
        acc = mmb_fwd(Bq + hf * 4608, Bq + (3 + 2 * hf) * 4608, mt * 32, nt * 32, lane, acc);
        const int col = nt * 32 + (lane & 31), hh = lane >> 5;
        if (hf == 0) {
            const float w0 = pw.w0a0;
#pragma unroll
            for (int i = 0; i < 16; ++i) {
                const float z = -(w0 + acc[i]);
                const float sp = z > 20.f ? z : __logf(1.f + __expf(z));
                X[4 * SLOT + (mt * 32 + crow(i, hh)) * LD + col] = -__expf(-sp - 0.5f);
            }
        } else {
            const float a0 = pw.w0a0;
#pragma unroll
            for (int i = 0; i < 16; ++i) X[5 * SLOT + (mt * 32 + crow(i, hh)) * LD + col] = __builtin_amdgcn_rcpf(1.f + __expf(-(a0 + acc[i])));
        }
    }
    LBAR();
    if (dry & 256) return;
    {
        float ldv[8], cs[8]; float run = 0.f;
#pragma unroll
        for (int tt = 0; tt < 8; ++tt) { ldv[tt] = X[4 * SLOT + (8 * wave + tt) * LD + j]; run += ldv[tt]; cs[tt] = run; }
        tot[wave * 64 + j] = run;
        LBAR();
        float off = 0.f, gC = 0.f;
#pragma unroll
        for (int w2 = 0; w2 < 8; ++w2) { const float v = tot[w2 * 64 + j]; off += (w2 < wave) ? v : 0.f; gC += v; }
        float tq[4][8]; float ctv = 0.f;
        float rr8[8], kkv8[8], km8[8], vx8[8], av8[8], xs[16];
#pragma unroll
        for (int tt = 0; tt < 8; ++tt) {
            const int t = 8 * wave + tt;
            const float r1 = bf2f(rr_[tt + 1]), k1 = bf2f(rk_[tt + 1]), v1 = bf2f(rv_[tt + 1]), r0 = bf2f(rr_[tt]), k0 = bf2f(rk_[tt]), v0 = bf2f(rv_[tt]);
            const float rr = r1 + (r0 - r1) * mu_r, kx = k1 + (k0 - k1) * mu_k;
            vx8[tt] = v1 + (v0 - v1) * mu_v;
            const float av = X[5 * SLOT + t * LD + j];
            const float kkv = kx * kkw, km = kx * (1.f + (av - 1.f) * kaw);
            rr8[tt] = rr; kkv8[tt] = kkv; km8[tt] = km; av8[tt] = av;
            xs[2 * tt] = kkv * kkv; xs[2 * tt + 1] = rr * km * rkw;
        }
        float tot16[16];
        {
            const bool b0 = (lane & 1) != 0, b1 = (lane & 2) != 0, b2 = (lane & 4) != 0, b3 = (lane & 8) != 0;
            float y[8], z[4], w2[2], u;
#pragma unroll
            for (int i = 0; i < 8; ++i) { const float lo = xs[i], hi = xs[i + 8]; y[i] = (b0 ? hi : lo) + dppx(b0 ? lo : hi, 0); }
#pragma unroll
            for (int i = 0; i < 4; ++i) { const float lo = y[i], hi = y[i + 4]; z[i] = (b1 ? hi : lo) + dppx(b1 ? lo : hi, 1); }
#pragma unroll
            for (int i = 0; i < 2; ++i) { const float lo = z[i], hi = z[i + 2]; w2[i] = (b2 ? hi : lo) + __builtin_bit_cast(float, __builtin_amdgcn_ds_swizzle(__builtin_bit_cast(int, b2 ? lo : hi), 0x101F)); }
            { const float lo = w2[0], hi = w2[1]; u = (b3 ? hi : lo) + __builtin_bit_cast(float, __builtin_amdgcn_ds_swizzle(__builtin_bit_cast(int, b3 ? lo : hi), 0x201F)); }
            u += __builtin_bit_cast(float, __builtin_amdgcn_ds_swizzle(__builtin_bit_cast(int, u), 0x401F));
            u += __shfl_xor(u, 32);
            const int iu = __builtin_bit_cast(int, u);
#pragma unroll
            for (int q = 0; q < 16; ++q) tot16[q] = __builtin_bit_cast(float, __builtin_amdgcn_readlane(iu, ((q >> 3) & 1) + 2 * ((q >> 2) & 1) + 4 * ((q >> 1) & 1) + 8 * (q & 1)));
        }
#pragma unroll
        for (int tt = 0; tt < 8; ++tt) {
            const int t = 8 * wave + tt;
            const float rr = rr8[tt], kkv = kkv8[tt], km = km8[tt], vx = vx8[tt], av = av8[tt];
            const float n2 = tot16[2 * tt], ct = tot16[2 * tt + 1];
            const float kap = kkv * __builtin_amdgcn_rsqf(fmaxf(n2, 1e-24f));
            const float be = kap * av;
            ctv = (lane == tt) ? ct : ctv;
            const float g = off + cs[tt];
            const float eg = __expf(g), egx = __expf(g - ldv[tt]), ieg = __expf(-g), ec = __expf(gC - g);
            LAS bf16* Bq = (LAS bf16*)X;
            Bq[0 * 4608 + t * 72 + j] = (bf16)f2bf(rr * eg); Bq[1 * 4608 + t * 72 + j] = (bf16)f2bf(kap * egx); Bq[3 * 4608 + t * 72 + j] = (bf16)f2bf(km * ieg); Bq[4 * 4608 + t * 72 + j] = (bf16)f2bf(be * ieg);
            tq[0][tt] = kap * egx; tq[1][tt] = vx; tq[2][tt] = km * ec; tq[3][tt] = be * ec;
        }
        if (lane < 8) { ctl[8 * wave + lane] = ctv; ((float*)(a.ws + WS_CT))[(mrow + 8 * wave + lane) * 8 + h] = ctv; }
        {
            LAS bf16* Bq = (LAS bf16*)X;
#pragma unroll
            for (int q = 0; q < 4; ++q) {
                u32x4 w; w.x = pk2(tq[q][0], tq[q][1]); w.y = pk2(tq[q][2], tq[q][3]); w.z = pk2(tq[q][4], tq[q][5]); w.w = pk2(tq[q][6], tq[q][7]);
                const int slot = q == 0 ? 2 * 4608 : q == 1 ? 5 * 4608 : q == 2 ? 6 * 4608 : 49920;
                *(LAS u32x4*)(Bq + slot + j * 72 + 8 * wave) = w;
            }
        }
        if (wave == 0) X[RW_SMALL + 576 + j] = __expf(gC);
    }
    LBAR();
}
__device__ __forceinline__ void rw_post(LAS float* X, const Args& a, int b, int h, int t0, int wave, int lane, const bf16 (&gt)[8], const float gw, const float gb, int dry) {
    bf16* G = (bf16*)(a.ws + WS_G);
    LAS float* ctl = X + RW_SMALL + 512;
    const int ch = h * 64 + lane;
    bf16* gp = G + ((size_t)b * SEQ + t0 + 8 * wave) * 1024 + ch;
    bf16* op = (dry & 1) ? (bf16*)(a.ws + 38 * MiB) + ((t0 + 8 * wave) & 4095) * 1024 + ch : gp;
#pragma unroll
    for (int tt = 0; tt < 8; ++tt) {
        const int t = 8 * wave + tt;
        const float y = X[5 * SLOT + t * LD + lane];
        const float mean = wave_sum(y) * (1.f / 64.f); const float d = y - mean;
        const float var = wave_sum(d * d) * (1.f / 64.f);
        const float o = d * __builtin_amdgcn_rsqf(var + 64e-5f) * gw + gb + ctl[t] * X[4 * SLOT + t * LD + lane];
        op[tt * 1024] = (bf16)f2bf(o * bf2f(gt[tt]));
    }
}
__device__ __forceinline__ unsigned pf_rw1(const Args& a, int item, int tid) {
    if (item >= 2048 || tid >= 325) return 0u;
    const int bh = item >> 7, c = item & 127, b = bh >> 3, h = bh & 7;
    const long m = (long)b * SEQ + c * 64 - 1 + tid / 5; const int sg = tid % 5;
    if (m < 0) return 0u;
    const int col = sg < 3 ? sg * 512 + h * 64 : 1536 + (sg - 3) * 64;
    return *(const unsigned*)((const bf16*)(a.ws + WS_SH) + m * SHW + col);
}
__device__ __forceinline__ unsigned pf_rw3(const Args& a, int item, int tid) {
    if (item >= 2048) return 0u;
    const int bh = item >> 7, c = item & 127, b = bh >> 3, h = bh & 7;
    const long mrow = (long)b * SEQ + c * 64;
    unsigned r = 0u;
    if (tid < 192) { const int w = tid >> 6, l = tid & 63;
        const char* p = w == 0 ? (const char*)((const bf16*)(a.ws + WS_SL) + (size_t)(item > 0 ? item - 1 : 0) * 4096) : w == 1 ? (const char*)((const bf16*)(a.ws + WS_YL) + (size_t)item * 4096) : (const char*)((const bf16*)(a.ws + WS_PY) + (size_t)item * 4096);
        r = *(const unsigned*)(p + l * 128); }
    else if (tid < 384) { }
    else { const int l = tid - 384;
        const long m = mrow + (l & 63);
        r = (l < 64) ? *(const unsigned*)((const bf16*)(a.ws + WS_G) + m * 1024 + h * 64) : *(const unsigned*)((const bf16*)(a.ws + WS_SH) + m * SHW + 1024 + h * 64); }
    return r;
}
__device__ __forceinline__ void pf_sink(const Args& a, unsigned v) { if (v == 0xDEADBEEFu) *(unsigned*)(a.ws + WS_DUMMY) = v; }

constexpr int BIMG = 4608;
constexpr int L_RT = 0, L_KT = BIMG, L_KTT = 2 * BIMG, L_KH = 3 * BIMG, L_BH = 4 * BIMG, L_VT = 5 * BIMG, L_KBT = 6 * BIMG;
constexpr int H_BBT = 49920, H_ABRT = 49920 + BIMG, H_AKK = 49920 + 2 * BIMG, H_TT = 49920 + 3 * BIMG;
constexpr int L_W1 = L_KH, L_W2 = L_BH, H_QYT = H_AKK, H_QST = H_TT;
__device__ __forceinline__ f32x16 mmb(const LAS bf16* A, const LAS bf16* B, int m0, int n0, int lane, f32x16 acc) {
    const LAS bf16* ap = A + (m0 + (lane & 31)) * 72 + 8 * (lane >> 5); const LAS bf16* bp = B + (n0 + (lane & 31)) * 72 + 8 * (lane >> 5);
#pragma unroll
    for (int s = 0; s < 4; ++s) acc = __builtin_amdgcn_mfma_f32_32x32x16_bf16(*(const LAS bf16x8*)(ap + 16 * s), *(const LAS bf16x8*)(bp + 16 * s), acc, 0, 0, 0);
    return acc;
}
__device__ __forceinline__ void st_t_lds(LAS bf16* dst, const f32x16& v, int m0, int col, int hh) {
#pragma unroll
    for (int g4 = 0; g4 < 4; ++g4) { u32x2 w; w.x = pk2(v[4 * g4], v[4 * g4 + 1]); w.y = pk2(v[4 * g4 + 2], v[4 * g4 + 3]); *(LAS u32x2*)(dst + col * 72 + m0 + 8 * g4 + 4 * hh) = w; }
}
__device__ __forceinline__ void st_t_glb(bf16* dst, const f32x16& v, int m0, int col, int hh) {
#pragma unroll
    for (int g4 = 0; g4 < 4; ++g4) { u32x2 w; w.x = pk2(v[4 * g4], v[4 * g4 + 1]); w.y = pk2(v[4 * g4 + 2], v[4 * g4 + 3]); *(u32x2*)(dst + col * 64 + m0 + 8 * g4 + 4 * hh) = w; }
}
__device__ __forceinline__ void rw1b_item(LAS float* X, const Args& a, int item, int tid, int wave, int lane, int dry, const RWP& pw) {
    const int bh = item >> 7, c = item & 127, b = bh >> 3, h = bh & 7;
    rw_prep<2>(X, a, b, h, c * 64, tid, wave, lane, dry, pw);
    if (dry & (16 | 128 | 256)) return;
    LAS bf16* Bq = (LAS bf16*)X; LAS float* XT = X + 4 * SLOT;
    const int hf = wave >> 2, m0 = ((wave >> 1) & 1) * 32, n0 = (wave & 1) * 32; int col = n0 + (lane & 31), hh = lane >> 5;
    asm volatile("" : "+v"(col), "+v"(hh));
    f32x16 acc1 = hf ? mmb(Bq + L_KT, Bq + L_KH, m0, n0, lane, zero16()) : mmb(Bq + L_BH, Bq + L_KT, m0, n0, lane, zero16());
    f32x16 acc2 = mmb(Bq + (hf ? L_KH : L_BH), Bq + L_RT, m0, n0, lane, zero16());
#pragma unroll
    for (int i = 0; i < 16; ++i) {
        const int row = m0 + crow(i, hh);
        acc2[i] = row <= col ? acc2[i] : 0.f;
        if (hf == 0) XT[row * LD + col] = row < col ? acc1[i] : 0.f; else acc1[i] = col < row ? acc1[i] : 0.f;
    }
    if (hf == 0) st_t_lds(Bq + H_ABRT, acc2, m0, col, hh); else st_t_lds(Bq + H_AKK, acc1, m0, col, hh);
    LBAR();
    if (!(dry & 32)) {
        const int lr = lane & 15, lq = lane >> 4;
        if (wave == 0) {
            int ii = lr; asm volatile("" : "+v"(ii)); const int base = lq * 16;
            float Tr[16];
#pragma unroll
            for (int t = 0; t < 16; ++t) {
                float s = (t == ii) ? 1.f : 0.f;
#pragma unroll
                for (int j = 0; j < t; ++j) s -= Tr[j] * XT[(base + j) * LD + base + t];
                Tr[t] = s;
            }
#pragma unroll
            for (int t = 0; t < 16; ++t) XT[(base + ii) * LD + base + t] = Tr[t];
        }
        LBAR();
        if (wave < 2) {
            const int base = 32 * wave;
            f32x4 x = {0.f, 0.f, 0.f, 0.f};
            float oa[4], ob[4];
#pragma unroll
            for (int s = 0; s < 4; ++s) { oa[s] = XT[(base + lr) * LD + base + 16 + 4 * s + lq]; ob[s] = XT[(base + 16 + 4 * s + lq) * LD + base + 16 + lr]; }
#pragma unroll
            for (int s = 0; s < 4; ++s) x = __builtin_amdgcn_mfma_f32_16x16x4f32(oa[s], ob[s], x, 0, 0, 0);
#pragma unroll
            for (int r = 0; r < 4; ++r) XT[(base + 4 * lq + r) * LD + base + 16 + lr] = x[r];
            f32x4 y = {0.f, 0.f, 0.f, 0.f};
#pragma unroll
            for (int s = 0; s < 4; ++s) { oa[s] = XT[(base + lr) * LD + base + 4 * s + lq]; ob[s] = XT[(base + 4 * s + lq) * LD + base + 16 + lr]; }
#pragma unroll
            for (int s = 0; s < 4; ++s) y = __builtin_amdgcn_mfma_f32_16x16x4f32(oa[s], ob[s], y, 0, 0, 0);
#pragma unroll
            for (int r = 0; r < 4; ++r) XT[(base + 4 * lq + r) * LD + base + 16 + lr] = -y[r];
        }
        LBAR();
        LAS float* XS = X + 5 * SLOT;
        const int tm = (wave >> 1) & 1, tn = wave & 1;
        if (wave < 4) {
            f32x4 x = {0.f, 0.f, 0.f, 0.f};
            float oa[8], ob[8];
#pragma unroll
            for (int s = 0; s < 8; ++s) { oa[s] = XT[(16 * tm + lr) * LD + 32 + 4 * s + lq]; ob[s] = XT[(32 + 4 * s + lq) * LD + 32 + 16 * tn + lr]; }
#pragma unroll
            for (int s = 0; s < 8; ++s) x = __builtin_amdgcn_mfma_f32_16x16x4f32(oa[s], ob[s], x, 0, 0, 0);
#pragma unroll
            for (int r = 0; r < 4; ++r) XS[(16 * tm + 4 * lq + r) * LD + 16 * tn + lr] = x[r];
        }
        LBAR();
        if (wave < 4) {
            f32x4 y = {0.f, 0.f, 0.f, 0.f};
            float oa[8], ob[8];
#pragma unroll
            for (int s = 0; s < 8; ++s) { oa[s] = XT[(16 * tm + lr) * LD + 4 * s + lq]; ob[s] = XS[(4 * s + lq) * LD + 16 * tn + lr]; }
#pragma unroll
            for (int s = 0; s < 8; ++s) y = __builtin_amdgcn_mfma_f32_16x16x4f32(oa[s], ob[s], y, 0, 0, 0);
#pragma unroll
            for (int r = 0; r < 4; ++r) XT[(16 * tm + 4 * lq + r) * LD + 32 + 16 * tn + lr] = -y[r];
        }
    }
    LBAR();
    {
        const int t = tid >> 3, jb = (tid & 7) * 8; float v[8];
#pragma unroll
        for (int e = 0; e < 8; ++e) v[e] = XT[(jb + e) * LD + t];
        u32x4 w; w.x = pk2(v[0], v[1]); w.y = pk2(v[2], v[3]); w.z = pk2(v[4], v[5]); w.w = pk2(v[6], v[7]);
        *(LAS u32x4*)(Bq + H_TT + t * 72 + jb) = w;
    }
    LBAR();
    if (dry & 64) return;
    acc1 = mmb(Bq + H_TT, Bq + (hf ? H_AKK : L_KTT), m0, n0, lane, zero16());
    st_t_lds(Bq + (hf ? L_W2 : L_W1), acc1, m0, col, hh);
    LBAR();
    acc1 = mmb(Bq + (hf ? L_W2 : L_W1), Bq + H_ABRT, m0, n0, lane, zero16());
    if (hf == 0) {
#pragma unroll
        for (int g4 = 0; g4 < 4; ++g4) { const u32x2 rv = *(const LAS u32x2*)(Bq + L_RT + col * 72 + m0 + 8 * g4 + 4 * hh);
            acc1[4 * g4] = bflo(rv.x) - acc1[4 * g4]; acc1[4 * g4 + 1] = bfhi(rv.x) - acc1[4 * g4 + 1]; acc1[4 * g4 + 2] = bflo(rv.y) - acc1[4 * g4 + 2]; acc1[4 * g4 + 3] = bfhi(rv.y) - acc1[4 * g4 + 3]; }
        st_t_glb((bf16*)(a.ws + WS_PY) + (size_t)item * 4096, acc1, m0, col, hh);
    } else {
#pragma unroll
        for (int i = 0; i < 16; ++i) acc1[i] = acc2[i] - acc1[i];
        st_t_lds(Bq + H_QYT, acc1, m0, col, hh);
    }
    LBAR();
    acc1 = mmb(Bq + (hf ? L_W2 : L_W1), Bq + H_BBT, m0, n0, lane, zero16());
    if (hf == 0) {
        const float gc = X[RW_SMALL + 576 + col];
#pragma unroll
        for (int i = 0; i < 16; ++i) acc1[i] = ((m0 + crow(i, hh)) == col ? gc : 0.f) - acc1[i];
        st_t_glb((bf16*)(a.ws + WS_PS) + (size_t)item * 4096, acc1, m0, col, hh);
    } else {
#pragma unroll
        for (int g4 = 0; g4 < 4; ++g4) { const u32x2 rv = *(const LAS u32x2*)(Bq + L_KBT + col * 72 + m0 + 8 * g4 + 4 * hh);
            acc1[4 * g4] = bflo(rv.x) - acc1[4 * g4]; acc1[4 * g4 + 1] = bfhi(rv.x) - acc1[4 * g4 + 1]; acc1[4 * g4 + 2] = bflo(rv.y) - acc1[4 * g4 + 2]; acc1[4 * g4 + 3] = bfhi(rv.y) - acc1[4 * g4 + 3]; }
        st_t_lds(Bq + H_QST, acc1, m0, col, hh);
    }
    LBAR();
    acc1 = mmb(Bq + L_VT, Bq + (hf ? H_QST : H_QYT), m0, n0, lane, zero16());
    if (hf == 0) st_t_glb((bf16*)(a.ws + WS_YL) + (size_t)item * 4096, acc1, m0, col, hh);
    else { bf16* o = (bf16*)(a.ws + WS_SL) + (size_t)item * 4096;
#pragma unroll
        for (int g4 = 0; g4 < 4; ++g4) { const int row = m0 + 8 * g4 + 4 * hh;
            u32x2 w; w.x = pk2(acc1[4 * g4], acc1[4 * g4 + 1]); w.y = pk2(acc1[4 * g4 + 2], acc1[4 * g4 + 3]);
            *(u32x2*)(o + ((((row >> 4) * 4 + (col >> 4)) * 64 + ((row >> 2) & 3) * 16 + (col & 15)) << 2)) = w; } }
    LBAR();
}
__device__ __forceinline__ void rw2b_scan(LAS float* X, const Args& a, int id, int tid, int wave, int lane, int dry) {
    const int bh = id >> 2, rg = id & 3;
    const bf16* PS = (const bf16*)(a.ws + WS_PS) + (size_t)bh * 128 * 4096;
    bf16* SL = (bf16*)(a.ws + WS_SL) + (size_t)bh * 128 * 4096;
    bf16* SLo = (dry & 1) ? (bf16*)(a.ws + 38 * MiB) + (size_t)(bh & 3) * 128 * 4096 : SL;
    LAS bf16* Sb = (LAS bf16*)X;
    for (int i = tid; i < 2 * 16 * 72 / 2; i += NT) ((LAS unsigned*)X)[i] = 0u;
    __syncthreads();
    const int n = wave & 3, lr = lane & 15, lq = lane >> 4;
    constexpr int D = 8;
    if (wave < 4) {
        bf16x8 pbv[D][2]; u32x2 iniv[D];
        const bf16* pbase = PS + (16 * n + lr) * 64 + 8 * lq;
        const size_t ioff = (size_t)((rg * 4 + n) * 64 + lane) * 4;
#pragma unroll
        for (int d = 0; d < D; ++d) { pbv[d][0] = *(const bf16x8*)(pbase + (size_t)d * 4096); pbv[d][1] = *(const bf16x8*)(pbase + (size_t)d * 4096 + 32); iniv[d] = *(const u32x2*)(SL + (size_t)d * 4096 + ioff); }
        for (int c0 = 0; c0 < NCHUNK; c0 += D) {
#pragma unroll
            for (int d = 0; d < D; ++d) {
                const int c = c0 + d;
                const LAS bf16* Sc = Sb + (d & 1) * 16 * 72; LAS bf16* Sn = Sb + ((d + 1) & 1) * 16 * 72;
                const bf16x8 a0 = *(const LAS bf16x8*)(Sc + lr * 72 + 8 * lq), a1 = *(const LAS bf16x8*)(Sc + lr * 72 + 32 + 8 * lq);
                f32x4 acc = {bflo(iniv[d].x), bfhi(iniv[d].x), bflo(iniv[d].y), bfhi(iniv[d].y)};
                acc = __builtin_amdgcn_mfma_f32_16x16x32_bf16(a0, pbv[d][0], acc, 0, 0, 0);
                acc = __builtin_amdgcn_mfma_f32_16x16x32_bf16(a1, pbv[d][1], acc, 0, 0, 0);
                u32x2 w; w.x = pk2(acc[0], acc[1]); w.y = pk2(acc[2], acc[3]);
                Sn[(4 * lq + 0) * 72 + 16 * n + lr] = (bf16)(w.x & 0xffffu); Sn[(4 * lq + 1) * 72 + 16 * n + lr] = (bf16)(w.x >> 16);
                Sn[(4 * lq + 2) * 72 + 16 * n + lr] = (bf16)(w.y & 0xffffu); Sn[(4 * lq + 3) * 72 + 16 * n + lr] = (bf16)(w.y >> 16);
                *(u32x2*)(SLo + (size_t)c * 4096 + ioff) = w;
                const int cn = c + D < NCHUNK ? c + D : NCHUNK - 1;
                pbv[d][0] = *(const bf16x8*)(pbase + (size_t)cn * 4096); pbv[d][1] = *(const bf16x8*)(pbase + (size_t)cn * 4096 + 32); iniv[d] = *(const u32x2*)(SL + (size_t)cn * 4096 + ioff);
                __syncthreads();
            }
        }
    } else {
        for (int c = 0; c < NCHUNK; ++c) __syncthreads();
    }
}
struct R3 { u32x4 s; u32x4 py; bf16 rv[9]; float ct, mu, gw, gb; u32x4 yl; bf16 gt[8]; };
__device__ __forceinline__ void rw3_load(R3& r, const Args& a, int item, int tid, int wave, int lane) {
    const int bh = item >> 7, c = item & 127, b = bh >> 3, h = bh & 7;
    const bf16* S0 = (const bf16*)(a.ws + WS_SL) + (size_t)(item > 0 ? item - 1 : 0) * 4096;
    const bf16* PY = (const bf16*)(a.ws + WS_PY) + (size_t)item * 4096;
    const bf16* YL = (const bf16*)(a.ws + WS_YL) + (size_t)item * 4096;
    const bf16* SH = (const bf16*)(a.ws + WS_SH);
    const size_t mrow = (size_t)b * SEQ + c * 64;
    const int v = tid >> 3, kb = (tid & 7) * 8, ch = h * 64 + lane;
    r.s = *(const u32x4*)(S0 + 8 * tid); r.yl = *(const u32x4*)(YL + 8 * tid);
    r.py = *(const u32x4*)(PY + v * 64 + kb);
#pragma unroll
    for (int tt = 0; tt < 9; ++tt) r.rv[tt] = (tt == 0 && c == 0 && wave == 0) ? (bf16)0 : SH[(mrow + 8 * wave + tt - 1) * SHW + 1024 + ch];
    r.ct = ((const float*)(a.ws + WS_CT))[(mrow + (tid & 63)) * 8 + h];
    r.mu = a.in[I_MU][1024 + ch]; r.gw = a.in[I_GNW][ch]; r.gb = a.in[I_GNB][ch];
    const bf16* gp = (const bf16*)(a.ws + WS_G) + (mrow + 8 * wave) * 1024 + ch;
#pragma unroll
    for (int tt = 0; tt < 8; ++tt) r.gt[tt] = gp[tt * 1024];
}
__device__ __forceinline__ void rw3_consume(const R3& r, LAS float* X, const Args& a, int item, int tid, int wave, int lane, int dry) {
    const int bh = item >> 7, c = item & 127, b = bh >> 3, h = bh & 7;
    LAS bf16* Bq = (LAS bf16*)X;
#pragma unroll
    for (int q = 0; q < 2; ++q) {
        const int e = 2 * tid + q, rg = e >> 8, n = (e >> 6) & 3, lq = (e >> 4) & 3, lr = e & 15, v0 = 16 * rg + 4 * lq, k = 16 * n + lr;
        const unsigned w0 = c > 0 ? (q ? r.s.z : r.s.x) : 0u, w1 = c > 0 ? (q ? r.s.w : r.s.y) : 0u;
        Bq[(v0 + 0) * 72 + k] = (bf16)(w0 & 0xffffu); Bq[(v0 + 1) * 72 + k] = (bf16)(w0 >> 16); Bq[(v0 + 2) * 72 + k] = (bf16)(w1 & 0xffffu); Bq[(v0 + 3) * 72 + k] = (bf16)(w1 >> 16);
    }
    {
        const int t = tid >> 3, vv = 8 * (tid & 7);
        X[5 * SLOT + t * LD + vv + 0] = bflo(r.yl.x); X[5 * SLOT + t * LD + vv + 1] = bfhi(r.yl.x); X[5 * SLOT + t * LD + vv + 2] = bflo(r.yl.y); X[5 * SLOT + t * LD + vv + 3] = bfhi(r.yl.y);
        X[5 * SLOT + t * LD + vv + 4] = bflo(r.yl.z); X[5 * SLOT + t * LD + vv + 5] = bfhi(r.yl.z); X[5 * SLOT + t * LD + vv + 6] = bflo(r.yl.w); X[5 * SLOT + t * LD + vv + 7] = bfhi(r.yl.w);
    }
    { const int v = tid >> 3, kb = (tid & 7) * 8; *(LAS u32x4*)(Bq + BIMG + v * 72 + kb) = r.py; }
    { const float mu_v = r.mu;
#pragma unroll
      for (int tt = 0; tt < 8; ++tt) { const float v1 = bf2f(r.rv[tt + 1]), v0 = bf2f(r.rv[tt]); X[4 * SLOT + (8 * wave + tt) * LD + lane] = v1 + (v0 - v1) * mu_v; } }
    if (tid < 64) X[RW_SMALL + 512 + tid] = r.ct;
    LBAR();
    if (wave < 4 && !(dry & 1024)) {
        const int m0 = ((wave >> 1) & 1) * 32, n0 = (wave & 1) * 32, col = n0 + (lane & 31), hh = lane >> 5;
        const f32x16 acc = mmb(Bq, Bq + BIMG, m0, n0, lane, zero16());
#pragma unroll
        for (int i = 0; i < 16; ++i) X[5 * SLOT + col * LD + m0 + crow(i, hh)] += acc[i];
    }
    LBAR();
    if (!(dry & 512)) rw_post(X, a, b, h, c * 64, wave, lane, r.gt, r.gw, r.gb, dry);
    LBAR();
}

__device__ __forceinline__ void final_norm(const Args& a, int wave, int lane) {
    const float* rs = (const float*)(a.ws + WS_ROWSS);
    const int gw = blockIdx.x * 8 + wave, NGW = gridDim.x * 8;
    f32x4 gv[4];
#pragma unroll
    for (int j = 0; j < 4; ++j) gv[j] = ((const f32x4*)a.in[I_GFIN])[lane + 64 * j];
    for (int m = gw; m < M; m += NGW) {
        const float sc = 1.f / sqrtf(rs[m] * (1.f / DM) + 1e-6f);
        f32x4* o = (f32x4*)(a.out + (size_t)m * DM) + lane;
#pragma unroll
        for (int j = 0; j < 4; ++j) o[64 * j] = o[64 * j] * sc * gv[j];
    }
}

#define XB_TMO      128
#define XB_XCNT(j)  (256  + 64 * (j))
#define XB_XSUB(j)  (1280 + 64 * (j))
#define XB_XGEN(j)  (2304 + 64 * (j))
#define XB_TOP      3328
#define XB_TOPGEN   3392
#define XCD_BAR_WORDS 3456
#define XB_SPIN_CAP (1u << 18)

__device__ __forceinline__ unsigned xb_ld(unsigned* p)              { return __hip_atomic_load(p, __ATOMIC_RELAXED, __HIP_MEMORY_SCOPE_AGENT); }
__device__ __forceinline__ unsigned xb_add(unsigned* p, unsigned v) { return __hip_atomic_fetch_add(p, v, __ATOMIC_RELAXED, __HIP_MEMORY_SCOPE_AGENT); }
__device__ __forceinline__ unsigned xb_xcc_id() { return (unsigned)__builtin_amdgcn_s_getreg((3 << 11) | 20) & 0xFu; }
#define XB_SPIN(cond, bar) do { unsigned _sp = 0; while (cond) { __builtin_amdgcn_s_sleep(1); \
    if ((++_sp & 255u) == 0u) { if (xb_ld(&(bar)[XB_TMO])) break; if (_sp > XB_SPIN_CAP) { atomicAdd(&(bar)[XB_TMO], 1u); break; } } } } while (0)

struct XcdBarrier {
    unsigned* bar; unsigned x;
    volatile LAS unsigned* st;
};

__device__ __forceinline__ XcdBarrier xcd_barrier_post(unsigned* bar, volatile LAS unsigned* st) {
    XcdBarrier b; b.bar = bar; b.x = xb_xcc_id(); b.st = st;
    if (threadIdx.x == 0) (void)xb_add(&bar[XB_XCNT(b.x)], 1u);
    return b;
}
__device__ __forceinline__ void xcd_barrier_complete(unsigned* bar, unsigned x, unsigned& nloc, unsigned& nx) {
    const unsigned G = gridDim.x * gridDim.y * gridDim.z;
    unsigned sum, cnt, mine, sp = 0u;
    for (;;) {
        sum = 0u; cnt = 0u; mine = 0u;
#pragma unroll
        for (unsigned j = 0; j < 16; ++j) { const unsigned c = xb_ld(&bar[XB_XCNT(j)]); sum += c; cnt += (c > 0u) ? 1u : 0u; mine = (j == x) ? c : mine; }
        if (sum == G) break;
        __builtin_amdgcn_s_sleep(1);
        if ((++sp & 255u) == 0u) { if (xb_ld(&bar[XB_TMO])) break; if (sp > XB_SPIN_CAP) { atomicAdd(&bar[XB_TMO], 1u); break; } }
    }
    nloc = mine > 0u ? mine : 1u; nx = cnt > 0u ? cnt : 1u;
}

__device__ __forceinline__ void xcd_barrier(const XcdBarrier& b) {
    asm volatile("s_waitcnt vmcnt(0)" ::: "memory");
    __syncthreads();
    if (threadIdx.x == 0) {
        unsigned* bar = b.bar;
        __builtin_amdgcn_s_waitcnt(0);
        unsigned nloc = b.st[0], nx = b.st[1];
        if (nloc == 0u) { xcd_barrier_complete(bar, b.x, nloc, nx); b.st[0] = nloc; b.st[1] = nx; }
        const unsigned old = xb_add(&bar[XB_XSUB(b.x)], 1u);
        const unsigned gen = old / nloc;
        if (old + 1u == (gen + 1u) * nloc) {
            __builtin_amdgcn_fence(__ATOMIC_RELEASE, "agent");
            asm volatile("s_waitcnt vmcnt(0)" ::: "memory");
            const unsigned og = xb_add(&bar[XB_TOP], 1u);
            const unsigned tg = og / nx;
            if (og + 1u == (tg + 1u) * nx) xb_add(&bar[XB_TOPGEN], 1u);
            else XB_SPIN(xb_ld(&bar[XB_TOPGEN]) == tg, bar);
            __builtin_amdgcn_fence(__ATOMIC_ACQUIRE, "agent");
            xb_add(&bar[XB_XGEN(b.x)], 1u);
            asm volatile("s_waitcnt vmcnt(0)" ::: "memory");
        } else {
            XB_SPIN(xb_ld(&bar[XB_XGEN(b.x)]) == gen, bar);
            __builtin_amdgcn_fence(__ATOMIC_ACQUIRE, "agent");
            asm volatile("s_waitcnt vmcnt(0)" ::: "memory");
        }
    }
    __syncthreads();
}

#define PROBE_REP_PHASE 0
#define PROBE_REP 0
#define PROBE_LO -1
#define PROBE_HI 0
#define PROBE_N 2
#define PROBE_DRY 0
__global__ void __launch_bounds__(NT, 2) mega(Args a) {
    extern __shared__ __attribute__((aligned(16))) unsigned char lds_raw[];
    LAS unsigned char* lds = (LAS unsigned char*)lds_raw;
    const int tid = threadIdx.x, lane = tid & 63, wave = __builtin_amdgcn_readfirstlane(tid >> 6);
    const int G = gridDim.x, bid = blockIdx.x;
    unsigned char* ws = a.ws;
    cg::grid_group grid = cg::this_grid();
    const int lo = a.ph_lo, hi = a.ph_hi;
#define IN(k) (lo <= (k) && (k) < hi)
#define SEAM(k) do { if (IN(k) && IN((k) + 1)) { if (a.use_xb) xcd_barrier(xbar); else grid.sync(); } } while (0)
    volatile LAS unsigned* xst = (volatile LAS unsigned*)(lds + LDS_BYTES - 64);
    if (tid < 2) xst[tid] = 0u;
    __syncthreads();
    unsigned* xbw = (unsigned*)(ws + WS_BAR);
    XcdBarrier xbar; xbar.bar = xbw; xbar.x = 0; xbar.st = xst;
    if (a.use_xb) xbar = xcd_barrier_post(xbw, xst);
    if (a.ph_hi > 1000) grid.sync();
    if (IN(0)) { p0_prologue(a, lds, tid, wave, lane); }
    SEAM(0);
    if (IN(1)) {
        pg8::Gemm g{(const pg8::bf16_t*)(ws + WS_HB), (const pg8::bf16_t*)(ws + WS_WIN), M, INCP, DM, DM, DM};
        pg8::StaticOrderRev S; S.init(M, INCP, G, bid);
        pg8::EpiIn E{(pg8::bf16_t*)(ws + WS_SH), (pg8::bf16_t*)(ws + WS_G), (pg8::bf16_t*)(ws + WS_QKV), (pg8::bf16_t*)a.out, a.in[I_BQKV]};
        pg8::gemm_phase<pg8::EpiIn, pg8::StaticOrderRev, true, true>(lds, g, S, E);
    }
    SEAM(1);
    const int rp = a.dry >> 16, rn = (a.dry >> 12) & 15; int dry = a.dry & 0xfff;
    if (IN(2)) for (int rep = (rp == 2 ? rn : 0); rep >= 0; --rep) {
        const int ist = G == 256 ? 1 : G, i0 = G == 256 ? bid * 8 : bid, iend = G == 256 ? bid * 8 + 8 : 2048;
        RWP pw; if (G == 256) rwp_load(pw, a, (i0 >> 7) & 7, wave, lane);
        for (int it = i0; it < iend; it += ist) { if (G != 256) rwp_load(pw, a, (it >> 7) & 7, wave, lane);
            const unsigned pf = 0u; rw1b_item((LAS float*)lds, a, it, tid, wave, lane, dry, pw); pf_sink(a, pf); }
    }
    SEAM(2);
    if (IN(3)) {
        const int d3 = dry;
        if (bid < 64) { const int sid = G == 256 ? (bid & 7) * 8 + (bid >> 3) : bid; if (!(d3 & 4)) rw2b_scan((LAS float*)lds, a, sid, tid, wave, lane, d3); }
        else if (!(d3 & 2)) {
            if (G == 256) { const int j = bid - 64, x = j & 7, q = j >> 3;
                { const int it = x * 24 + q; attn_item(lds, a, it >> 7, (it >> 1) & 63, it & 1, tid, wave, lane, d3); }
                if (j < 64) { const int it = 192 + x * 8 + q; attn_item(lds, a, it >> 7, (it >> 1) & 63, it & 1, tid, wave, lane, d3); } }
            else for (int it = bid - 64; it < 256; it += G - 64) attn_item(lds, a, it >> 7, (it >> 1) & 63, it & 1, tid, wave, lane, d3);
        }
    }
    SEAM(3);
    if (IN(4)) for (int rep = (rp == 4 ? rn : 0); rep >= 0; --rep) {
        const int d4 = dry | (rep > 0 ? 1 : 0);
        const int ist = G == 256 ? 1 : G, i0 = G == 256 ? bid * 8 : bid, iend = G == 256 ? bid * 8 + 8 : 2048;
        R3 cur; rw3_load(cur, a, i0, tid, wave, lane);
        for (int it = i0; it < iend; it += ist) {
            const unsigned pf = 0u;
            R3 nxt; rw3_load(nxt, a, it + ist < iend ? it + ist : it, tid, wave, lane);
            rw3_consume(cur, (LAS float*)lds, a, it, tid, wave, lane, d4);
            cur = nxt; pf_sink(a, pf);
        }
    }
    SEAM(4);
    if (IN(5)) {
        pg8::StaticOrderK2 S; S.init(M, DM, G, bid);
        pg8::Gemm g{(const pg8::bf16_t*)(ws + WS_G), (const pg8::bf16_t*)(ws + WS_WBR), M, DM, RW, DM, DM};
        pg8::EpiMerge E{(const unsigned char*)a.out, (pg8::bf16_t*)(ws + WS_MG)};
        pg8::gemm_phase<pg8::EpiMerge, pg8::StaticOrderK2, true, true>(lds, g, S, E);
    }
    SEAM(5);
    if (IN(6)) {
        pg8::Gemm g{(const pg8::bf16_t*)(ws + WS_MG), (const pg8::bf16_t*)(ws + WS_WOUT), M, DM, DM, DM, DM};
        pg8::StaticOrder S; S.init(M, DM, G, bid);
        if (G == 256) {
            pg8::EpiOutNorm E{a.in[I_X], a.out, (float*)(ws + WS_ROWSS), (unsigned*)(ws + WS_PCNT), a.in[I_GFIN]};
            pg8::gemm_phase<pg8::EpiOutNorm, pg8::StaticOrder, false, true>(lds, g, S, E);
        }
    }
    if (rp == 8 && a.use_xb) for (int r_ = 0; r_ < rn; ++r_) xcd_barrier(xbar);
#undef IN
#undef SEAM
}

constexpr int N_PHASES = 7;
extern "C" void kernel_launch(void* const* d_in, const int* in_sizes, int n_in, void* d_out, int out_size, void* d_ws, size_t ws_size, hipStream_t stream) {
    static int grid = 0;
    if (grid == 0) {
        int dev = 0, cus = 0, per_cu = 0;
        (void)hipGetDevice(&dev);
        (void)hipDeviceGetAttribute(&cus, hipDeviceAttributeMultiprocessorCount, dev);
        if (hipFuncSetAttribute((const void*)mega, hipFuncAttributeMaxDynamicSharedMemorySize, LDS_BYTES) != hipSuccess) fprintf(stderr, "kernel_launch: hipFuncSetAttribute failed\n");
        if (hipOccupancyMaxActiveBlocksPerMultiprocessor(&per_cu, (const void*)mega, NT, LDS_BYTES) != hipSuccess || per_cu < 1) { fprintf(stderr, "kernel_launch: occupancy query says %d\n", per_cu); per_cu = 1; }
        (void)hipGetLastError();
        grid = cus > 0 ? cus : 256;
        fprintf(stderr, "kernel_launch: grid %d (per_cu %d)\n", grid, per_cu);
    }
    Args a{};
    for (int i = 0; i < 19; ++i) a.in[i] = (const float*)d_in[i];
    a.out = (float*)d_out; a.ws = (unsigned char*)d_ws;
    void* args[] = {&a};
    a.use_xb = 1;
    if (PROBE_LO < 0) {
        a.ph_lo = 0; a.ph_hi = N_PHASES; a.dry = (PROBE_REP_PHASE << 16) | (PROBE_REP << 12);
        (void)hipMemsetAsync((char*)d_ws + WS_BAR, 0, XCD_BAR_WORDS * 4, stream);
        hipError_t e = hipLaunchCooperativeKernel((const void*)mega, dim3(grid), dim3(NT), args, LDS_BYTES, stream);
        if (e != hipSuccess) fprintf(stderr, "kernel_launch: cooperative launch failed: %s\n", hipGetErrorString(e));
    } else {
#define PLAUNCH(l, h) do { (void)hipMemsetAsync((char*)d_ws + WS_BAR, 0, XCD_BAR_WORDS * 4, stream); a.ph_lo = (l); a.ph_hi = (h); (void)hipLaunchCooperativeKernel((const void*)mega, dim3(grid), dim3(NT), args, LDS_BYTES, stream); } while (0)
        if (PROBE_LO > 0) PLAUNCH(0, PROBE_LO);
        a.dry = PROBE_DRY; for (int r = 0; r < PROBE_N; ++r) PLAUNCH(PROBE_LO, PROBE_HI);
        a.dry = 0; PLAUNCH(PROBE_LO, N_PHASES);
    }
}
```

```cpp
#include <hip/hip_runtime.h>
#include <hip/hip_cooperative_groups.h>
#include <cstdio>
#include <cstdint>
namespace cg = cooperative_groups;
namespace pg8 {
#define PG8_LAS __attribute__((address_space(3)))
typedef unsigned short bf16_t;
typedef short bf16x8 __attribute__((ext_vector_type(8)));
typedef float f32x4 __attribute__((ext_vector_type(4)));
typedef unsigned u32x4 __attribute__((ext_vector_type(4)));
constexpr int BM = 256, BK = 64, HALF = 128, HTB = HALF * BK * 2  , STAGE_BYTES = 8 * HTB, NXCD = 8, WGM = 8;

__host__ __device__ __forceinline__ int lds_byte(int r, int c) { const int st = (r >> 4) * 2 + (c >> 5), rr = r & 15, cc = c & 31, ob = rr * 64 + cc * 2; return st * 1024 + (ob ^ (((ob >> 9) & 1) << 5)); }
__host__ __device__ __forceinline__ void stage_rc(int b, int& R, int& C) { const int st = b / 1024, sb = b % 1024, swz = sb ^ (((sb >> 9) & 1) << 5); R = (st >> 1) * 16 + swz / 64; C = (st & 1) * 32 + (swz % 64) / 2; }
__host__ __device__ __forceinline__ int perm32(int rho) { const int n = rho >> 4, i = rho & 15; return 8 * (i >> 2) + 4 * n + (i & 3); }

struct Unit { int pm, pn, kh; };
struct Gemm { const bf16_t* A; const bf16_t* Bt; int M, N, K, lda, ldb; };

struct StaticOrder {
    int nM, nN, nwg, G, c;
    __host__ __device__ void init(int M, int N, int G_, int c_) { nM = M / BM; nN = N / BM; nwg = nM * nN; G = G_; c = c_; }
    __host__ __device__ bool next(int i, Unit& u) const {
        const long L = (long)i * G + c; if (L >= nwg) return false;
        int wgid = (int)L; { const int q = nwg / NXCD, r = nwg % NXCD, xcd = wgid % NXCD, off = wgid / NXCD; wgid = (xcd < r ? xcd * (q + 1) : r * (q + 1) + (xcd - r) * q) + off; }
        const int nig = WGM * nN, gid = wgid / nig, fm = gid * WGM, gsz = (nM - fm) < WGM ? (nM - fm) : WGM;
        u.pm = fm + ((wgid % nig) % gsz); u.pn = (wgid % nig) / gsz; u.kh = 0; return true;
    }
    __device__ __forceinline__ void a_ready(const Unit&) const {}
    __device__ __forceinline__ void done(const Unit&) const {}
};

__device__ __forceinline__ unsigned cvt_pk_bf16(float lo, float hi) { unsigned r; asm volatile("v_cvt_pk_bf16_f32 %0, %1, %2" : "=v"(r) : "v"(lo), "v"(hi)); return r; }
typedef float f32x2 __attribute__((ext_vector_type(2)));
struct StaticOrderRev {
    StaticOrder so;
    __host__ __device__ void init(int M, int N, int G_, int c_) { so.init(M, N, G_, c_); }
    __host__ __device__ bool next(int i, Unit& u) const { if (!so.next(i, u)) return false; u.pn = so.nN - 1 - u.pn; return true; }
    __device__ __forceinline__ void a_ready(const Unit&) const {}
    __device__ __forceinline__ void done(const Unit&) const {}
};
struct StaticOrderK2 {
    StaticOrder so;
    __host__ __device__ void init(int M, int N, int G_, int c_) { so.init(M, N, G_, c_); }
    __host__ __device__ bool next(int i, Unit& u) const { if (!so.next(i >> 1, u)) return false; u.kh = i & 1; return true; }
    __device__ __forceinline__ void a_ready(const Unit&) const {}
    __device__ __forceinline__ void done(const Unit&) const {}
};
template <class Epi, class Sched, bool ALIGN_EPI = false, bool SP2 = false>
__device__ __forceinline__ void gemm_phase(PG8_LAS unsigned char* lds, const Gemm g, const Sched& S, const Epi& E) {
    const int tid = threadIdx.x, wid = __builtin_amdgcn_readfirstlane(tid >> 6), lane = tid & 63, wr = wid >> 2, wc = wid & 3, fr = lane & 15, fq = lane >> 4;
    const int K = g.K, nt = K / BK;
    unsigned voffA[2], voffB[2];
#pragma unroll
    for (int i = 0; i < 2; ++i) { int R, C; stage_rc(tid * 16 + i * 8192, R, C); const int Rb = Epi::PERM ? ((R & ~31) + perm32(R & 31)) : R;
        voffA[i] = (unsigned)(R * g.lda + C) * 2u; voffB[i] = (unsigned)(Rb * g.ldb + C) * 2u; }
    const size_t kstep = (size_t)(BK * 2);
    const size_t hstepA = (size_t)HALF * g.lda * 2, hstepB = (size_t)HALF * g.ldb * 2;
    const size_t tstepA = 2 * hstepA, tstepB = 2 * hstepB;
    const unsigned ldsw = (unsigned)wid * 1024u;
    const int aoff = lds_byte(wr * 64 + fr, fq * 8), boff = lds_byte(wc * 32 + fr, fq * 8);
#define PG8_SA(b, h) (((b) * 2 + (h)) * HTB)
#define PG8_SB(b, h) ((4 + (b) * 2 + (h)) * HTB)
#define PG8_STAGE(bufoff, gbase, voff) do { _Pragma("unroll") for (int _i = 0; _i < 2; ++_i) \
        __builtin_amdgcn_global_load_lds((const unsigned*)((const char*)(gbase) + (voff)[_i]), (PG8_LAS unsigned*)(lds + (bufoff) + ldsw + _i * 8192), 16, 0, 0); } while (0)
#define PG8_LDA(dst, b, h) do { _Pragma("unroll") for (int m = 0; m < 4; ++m) _Pragma("unroll") for (int k = 0; k < 2; ++k) dst[m][k] = *(const PG8_LAS bf16x8*)(lds + PG8_SA(b, h) + aoff + m * 2048 + k * 1024); } while (0)
#define PG8_LDB(dst, b, h) do { _Pragma("unroll") for (int n = 0; n < 2; ++n) _Pragma("unroll") for (int k = 0; k < 2; ++k) dst[n][k] = *(const PG8_LAS bf16x8*)(lds + PG8_SB(b, h) + boff + n * 2048 + k * 1024); } while (0)
#define PG8_MMA(ai, bj, At, Bt) do { __builtin_amdgcn_s_setprio(1); _Pragma("unroll") for (int m = 0; m < 4; ++m) _Pragma("unroll") for (int n = 0; n < 2; ++n) _Pragma("unroll") for (int k = 0; k < 2; ++k) \
        acc[ai][bj][m][n] = __builtin_amdgcn_mfma_f32_16x16x32_bf16(Bt[n][k], At[m][k], acc[ai][bj][m][n], 0, 0, 0); __builtin_amdgcn_s_setprio(0); } while (0)
#define PG8_WAIT_V(n) asm volatile("s_waitcnt vmcnt(" #n ")" ::: "memory")
#define PG8_WAIT_L(n) asm volatile("s_waitcnt lgkmcnt(" #n ")" ::: "memory")
#define PG8_BAR __builtin_amdgcn_s_barrier()
#define PG8_SCHED __builtin_amdgcn_sched_barrier(0)
    Unit cur, nxt; int ui = 0;
    if (!S.next(0, cur)) return;
    f32x4 acc[2][2][4][2];
#pragma unroll
    for (int a = 0; a < 2; ++a)
#pragma unroll
        for (int b = 0; b < 2; ++b)
#pragma unroll
            for (int m = 0; m < 4; ++m)
#pragma unroll
                for (int n = 0; n < 2; ++n) acc[a][b][m][n] = (f32x4){0.f, 0.f, 0.f, 0.f};
    bf16x8 At[4][2], B0[2][2], B1[2][2];
    const char* cA = (const char*)g.A + (size_t)cur.pm * tstepA + (size_t)cur.kh * K * 2; const char* cB = (const char*)g.Bt + (size_t)cur.pn * tstepB + (size_t)cur.kh * K * 2;
    S.a_ready(cur);
    if constexpr (SP2) {
        PG8_STAGE(PG8_SB(0, 0), cB, voffB); PG8_STAGE(PG8_SB(0, 1), cB + hstepB, voffB); PG8_STAGE(PG8_SA(0, 0), cA, voffA); PG8_STAGE(PG8_SA(0, 1), cA + hstepA, voffA);
        if (wr == 1) PG8_BAR;
        PG8_WAIT_V(2); PG8_BAR;
        PG8_STAGE(PG8_SB(1, 0), cB + kstep, voffB); PG8_STAGE(PG8_SA(1, 0), cA + kstep, voffA); PG8_STAGE(PG8_SB(1, 1), cB + hstepB + kstep, voffB);
        PG8_WAIT_V(6); PG8_BAR;
    } else {
        PG8_STAGE(PG8_SB(0, 0), cB, voffB); PG8_STAGE(PG8_SA(0, 0), cA, voffA); PG8_STAGE(PG8_SB(0, 1), cB + hstepB, voffB); PG8_STAGE(PG8_SA(0, 1), cA + hstepA, voffA);
        if (wr == 1) PG8_BAR;
        PG8_WAIT_V(4); PG8_BAR;
        PG8_STAGE(PG8_SB(1, 0), cB + kstep, voffB); PG8_STAGE(PG8_SA(1, 0), cA + kstep, voffA); PG8_STAGE(PG8_SB(1, 1), cB + hstepB + kstep, voffB);
        PG8_WAIT_V(6); PG8_BAR;
    }
    for (;;) {
        const bool has_next = S.next(ui + 1, nxt);
        const char* nA = has_next ? (const char*)g.A + (size_t)nxt.pm * tstepA + (size_t)nxt.kh * K * 2 : cA; const char* nB = has_next ? (const char*)g.Bt + (size_t)nxt.pn * tstepB + (size_t)nxt.kh * K * 2 : cB;
        for (int t = 0; t < nt; t += 2) {
            const bool last = (t == nt - 2);
            const char* a1 = cA + (size_t)(t + 1) * kstep;
            const char* a2 = last ? nA : cA + (size_t)(t + 2) * kstep; const char* b2 = last ? nB : cB + (size_t)(t + 2) * kstep;
            const char* a3 = a2 + kstep; const char* b3 = b2 + kstep;
            if (last && has_next) S.a_ready(nxt);
            if constexpr (SP2) {
            PG8_LDB(B0, 0, 0); PG8_LDB(B1, 0, 1); PG8_SCHED; PG8_LDA(At, 0, 0); PG8_STAGE(PG8_SA(1, 1), a1 + hstepA, voffA);
            PG8_WAIT_V(8); PG8_WAIT_L(0); PG8_BAR; PG8_MMA(0, 0, At, B0); PG8_MMA(0, 1, At, B1); PG8_BAR; PG8_SCHED;
            PG8_LDA(At, 0, 1); PG8_STAGE(PG8_SB(0, 0), b2, voffB); PG8_STAGE(PG8_SB(0, 1), b2 + hstepB, voffB); PG8_STAGE(PG8_SA(0, 0), a2, voffA);
            PG8_WAIT_V(8); PG8_WAIT_L(0); PG8_BAR; PG8_MMA(1, 0, At, B0); PG8_MMA(1, 1, At, B1); PG8_BAR; PG8_SCHED;
            PG8_LDB(B0, 1, 0); PG8_LDB(B1, 1, 1); PG8_SCHED; PG8_LDA(At, 1, 0); PG8_STAGE(PG8_SA(0, 1), a2 + hstepA, voffA);
            PG8_WAIT_V(8); PG8_WAIT_L(0); PG8_BAR; PG8_MMA(0, 0, At, B0); PG8_MMA(0, 1, At, B1); PG8_BAR; PG8_SCHED;
            PG8_LDA(At, 1, 1); PG8_STAGE(PG8_SB(1, 0), b3, voffB); PG8_STAGE(PG8_SB(1, 1), b3 + hstepB, voffB); PG8_STAGE(PG8_SA(1, 0), a3, voffA);
            PG8_WAIT_V(8); PG8_WAIT_L(0); PG8_BAR; PG8_MMA(1, 0, At, B0); PG8_MMA(1, 1, At, B1); PG8_BAR; PG8_SCHED;
            } else {
            PG8_LDB(B0, 0, 0); PG8_SCHED; PG8_LDA(At, 0, 0); PG8_STAGE(PG8_SA(1, 1), a1 + hstepA, voffA);
            PG8_WAIT_L(8); PG8_BAR; PG8_WAIT_L(0); PG8_MMA(0, 0, At, B0); PG8_BAR; PG8_SCHED;
            PG8_LDB(B1, 0, 1); PG8_STAGE(PG8_SB(0, 0), b2, voffB);
            PG8_BAR; PG8_WAIT_L(0); PG8_MMA(0, 1, At, B1); PG8_BAR;
            PG8_LDA(At, 0, 1); PG8_STAGE(PG8_SA(0, 0), a2, voffA);
            PG8_BAR; PG8_WAIT_L(0); PG8_MMA(1, 0, At, B0); PG8_BAR; PG8_SCHED;
            PG8_STAGE(PG8_SB(0, 1), b2 + hstepB, voffB);
            PG8_WAIT_V(6); PG8_BAR; PG8_MMA(1, 1, At, B1); PG8_BAR;
            PG8_LDB(B0, 1, 0); PG8_SCHED; PG8_LDA(At, 1, 0); PG8_STAGE(PG8_SA(0, 1), a2 + hstepA, voffA);
            PG8_WAIT_L(8); PG8_BAR; PG8_WAIT_L(0); PG8_MMA(0, 0, At, B0); PG8_BAR; PG8_SCHED;
            PG8_LDB(B1, 1, 1); PG8_STAGE(PG8_SB(1, 0), b3, voffB);
            PG8_BAR; PG8_WAIT_L(0); PG8_MMA(0, 1, At, B1); PG8_BAR;
            PG8_LDA(At, 1, 1); PG8_STAGE(PG8_SA(1, 0), a3, voffA);
            PG8_BAR; PG8_WAIT_L(0); PG8_MMA(1, 0, At, B0); PG8_BAR; PG8_SCHED;
            PG8_STAGE(PG8_SB(1, 1), b3 + hstepB, voffB);
            PG8_WAIT_V(6); PG8_BAR; PG8_MMA(1, 1, At, B1); PG8_BAR;
            }
        }
        if constexpr (ALIGN_EPI) { if (wr == 0) PG8_BAR; }
        if constexpr (!Epi::AFTER_DRAIN) { E(acc, cur, wr, wc, fr, fq); S.done(cur); }
        if (!has_next) break;
        if (!(Epi::KEEP && cur.kh == 0)) {
#pragma unroll
        for (int a = 0; a < 2; ++a)
#pragma unroll
            for (int b = 0; b < 2; ++b)
#pragma unroll
                for (int m = 0; m < 4; ++m)
#pragma unroll
                    for (int n = 0; n < 2; ++n) acc[a][b][m][n] = (f32x4){0.f, 0.f, 0.f, 0.f};
        }
        cur = nxt; cA = nA; cB = nB; ++ui;
        if constexpr (ALIGN_EPI) { if (wr == 1) PG8_BAR; }
    }
    PG8_WAIT_V(0);
    if constexpr (!ALIGN_EPI) { if (wr == 0) PG8_BAR; }
    PG8_BAR;
    if constexpr (Epi::AFTER_DRAIN) { E.fused(acc, cur, wr, wc, fr, fq, lds, wid, lane); S.done(cur); }
#undef PG8_SA
#undef PG8_SB
#undef PG8_STAGE
#undef PG8_LDA
#undef PG8_LDB
#undef PG8_MMA
#undef PG8_WAIT_V
#undef PG8_WAIT_L
#undef PG8_BAR
#undef PG8_SCHED
}
}

#define GAS __attribute__((address_space(1)))
#define LAS __attribute__((address_space(3)))
typedef unsigned short bf16;
typedef unsigned u32x4 __attribute__((ext_vector_type(4)));
typedef unsigned u32x2 __attribute__((ext_vector_type(2)));
typedef float f32x4 __attribute__((ext_vector_type(4)));
typedef float f32x16 __attribute__((ext_vector_type(16)));
typedef short bf16x8 __attribute__((ext_vector_type(8)));
typedef short s16x4 __attribute__((ext_vector_type(4)));

constexpr int NT = 512;
constexpr int BATCH = 2, SEQ = 8192, DM = 1024, M = BATCH * SEQ;
constexpr int NH = 8, HD = 64, RW = 512;
constexpr int SHW = 1664, INC = 5504, INCP = 5632;
constexpr int QKVW = 768;
constexpr int NCHUNK = SEQ / 64;
constexpr size_t MiB = 1u << 20;
constexpr size_t WS_ROWSS = 0;
constexpr size_t WS_BAR = 1024 * 1024;
constexpr size_t WS_PCNT = 1280 * 1024;
constexpr size_t WS_DUMMY = 1536 * 1024;
constexpr size_t WS_CT = 256 * 1024;
constexpr size_t WS_WBR = 2 * MiB, WS_WOUT = 4 * MiB, WS_WIN = 6 * MiB;
constexpr size_t WS_HB = 17 * MiB;
constexpr size_t WS_SH = 49 * MiB;
constexpr size_t WS_G = 101 * MiB;
constexpr size_t WS_QKV = 133 * MiB;
constexpr size_t WS_PS = 157 * MiB;
constexpr size_t WS_SL = 189 * MiB;
constexpr size_t WS_PY = 221 * MiB;
constexpr size_t WS_YL = 6 * MiB;
constexpr size_t WS_MG = WS_PS;
constexpr int LDS_BYTES = 147456;

struct Args {
    const float* in[19]; float* out; unsigned char* ws; int ph_lo, ph_hi, use_xb, dry;
};
enum { I_X = 0, I_GPRE, I_WIN, I_MU, I_W0, I_WDU, I_A0, I_WIU, I_KK, I_KA, I_RK, I_GNW, I_GNB, I_BQKV, I_SINKS, I_WBR, I_WBA, I_WOUT, I_GFIN };

typedef float f32x2_t __attribute__((ext_vector_type(2)));
typedef __bf16 bf16x2_t __attribute__((ext_vector_type(2)));
__device__ __forceinline__ unsigned pk2(float lo, float hi) { const f32x2_t v = {lo, hi}; const bf16x2_t b = __builtin_convertvector(v, bf16x2_t); return __builtin_bit_cast(unsigned, b); }
__device__ __forceinline__ unsigned f2bf(float f) { return pk2(f, 0.f) & 0xffffu; }
__device__ __forceinline__ float bf2f(unsigned short b) { return __builtin_bit_cast(float, (unsigned)b << 16); }
__device__ __forceinline__ float bflo(unsigned w) { return __builtin_bit_cast(float, w << 16); }
__device__ __forceinline__ float bfhi(unsigned w) { return __builtin_bit_cast(float, w & 0xffff0000u); }
__device__ __forceinline__ float dppx(float x, const int sel) {
    const int v = __builtin_bit_cast(int, x); int r;
    if (sel == 0) r = __builtin_amdgcn_update_dpp(0, v, 0xB1, 0xF, 0xF, true);
    else if (sel == 1) r = __builtin_amdgcn_update_dpp(0, v, 0x4E, 0xF, 0xF, true);
    else if (sel == 2) r = __builtin_amdgcn_update_dpp(0, v, 0x141, 0xF, 0xF, true);
    else r = __builtin_amdgcn_update_dpp(0, v, 0x140, 0xF, 0xF, true);
    return __builtin_bit_cast(float, r);
}
__device__ __forceinline__ float wave_sum(float v) {
    v += dppx(v, 0); v += dppx(v, 1); v += dppx(v, 2); v += dppx(v, 3);
    const int iv = __builtin_bit_cast(int, v);
    const float r0 = __builtin_bit_cast(float, __builtin_amdgcn_readlane(iv, 0)), r1 = __builtin_bit_cast(float, __builtin_amdgcn_readlane(iv, 16));
    const float r2 = __builtin_bit_cast(float, __builtin_amdgcn_readlane(iv, 32)), r3 = __builtin_bit_cast(float, __builtin_amdgcn_readlane(iv, 48));
    return (r0 + r1) + (r2 + r3);
}
__device__ __forceinline__ float sigmoidf_(float x) { return __builtin_amdgcn_rcpf(1.f + __expf(-x)); }
__device__ __forceinline__ float siluf_(float x) { return x * __builtin_amdgcn_rcpf(1.f + __expf(-x)); }

namespace pg8 {
struct EpiIn {
    static constexpr bool PERM = true, AFTER_DRAIN = false, MID = false, KEEP = false;
    bf16_t *SH, *G, *QKV, *GT; const float* bqkv;
    __device__ __forceinline__ void operator()(const f32x4 (&acc)[2][2][4][2], const Unit& u, int wr, int wc, int fr, int fq) const {
        const int row0 = u.pm * BM + wr * 64 + fr;
#pragma unroll
        for (int bj = 0; bj < 2; ++bj) {
            const int c128 = u.pn * 2 + bj;
            if (c128 >= 43) continue;
            const int col = c128 * 128 + wc * 32 + 8 * fq;
            int kind, ld, dcol; bf16_t* base;
            if (c128 < 13) { kind = 0; base = SH; ld = 1664; dcol = col; }
            else if (c128 < 17) { kind = 1; base = G; ld = 1024; dcol = col - 1664; }
            else if (c128 < 23) { kind = 2; base = QKV; ld = 768; dcol = col - 2176; }
            else if (c128 < 27) { kind = 1; base = G; ld = 1024; dcol = col - 2944 + 512; }
            else { kind = 3; base = GT; ld = 2048; dcol = col - 3456; }
            f32x4 b0 = {0.f, 0.f, 0.f, 0.f}, b1 = {0.f, 0.f, 0.f, 0.f}; float sc = 1.f;
            if (kind == 2) { b0 = *(const f32x4*)(bqkv + dcol); b1 = *(const f32x4*)(bqkv + dcol + 4); sc = dcol < 512 ? 0.125f : 1.f; }
#pragma unroll
            for (int ai = 0; ai < 2; ++ai)
#pragma unroll
                for (int m = 0; m < 4; ++m) {
                    f32x4 v0 = acc[ai][bj][m][0], v1 = acc[ai][bj][m][1];
                    if (kind == 1) {
#pragma unroll
                        for (int e = 0; e < 4; ++e) { v0[e] = v0[e] * sigmoidf_(v0[e]); v1[e] = v1[e] * sigmoidf_(v1[e]); }
                    } else if (kind == 2) { v0 = (v0 + b0) * sc; v1 = (v1 + b1) * sc; }
                    else if (kind == 3) {
#pragma unroll
                        for (int e = 0; e < 4; ++e) { v0[e] = sigmoidf_(v0[e]); v1[e] = sigmoidf_(v1[e]); }
                    }
                    if (kind == 3) {
                        u32x2 w8 = {0u, 0u};
#pragma unroll
                        for (int e = 0; e < 4; ++e) { w8.x = __builtin_amdgcn_cvt_pk_u8_f32(fmaxf(v0[e] * 255.f, 1.f), e, w8.x); w8.y = __builtin_amdgcn_cvt_pk_u8_f32(fmaxf(v1[e] * 255.f, 1.f), e, w8.y); }
                        *(u32x2*)((unsigned char*)GT + (size_t)(row0 + ai * HALF + m * 16) * 2048 + dcol) = w8;
                    } else {
                    u32x4 w; w.x = cvt_pk_bf16(v0[0], v0[1]); w.y = cvt_pk_bf16(v0[2], v0[3]); w.z = cvt_pk_bf16(v1[0], v1[1]); w.w = cvt_pk_bf16(v1[2], v1[3]);
                    *(u32x4*)(base + (size_t)(row0 + ai * HALF + m * 16) * ld + dcol) = w;
                    }
                }
        }
    }
};
struct EpiMerge {
    static constexpr bool PERM = true, AFTER_DRAIN = false, MID = false, KEEP = true;
    const unsigned char* GT; bf16_t* MG;
    __device__ __forceinline__ void operator()(f32x4 (&acc)[2][2][4][2], const Unit& u, int wr, int wc, int fr, int fq) const {
        const int row0 = u.pm * BM + wr * 64 + fr;
        if (u.kh == 0) {
#pragma unroll
            for (int ai = 0; ai < 2; ++ai)
#pragma unroll
                for (int m = 0; m < 4; ++m)
#pragma unroll
                    for (int bj = 0; bj < 2; ++bj) {
                        const unsigned char* gp = GT + (size_t)(row0 + ai * HALF + m * 16) * 2048 + u.pn * BM + bj * HALF + wc * 32 + 8 * fq;
                        const u32x2 gr = *(const u32x2*)gp, ga = *(const u32x2*)(gp + 1024);
#pragma unroll
                        for (int e = 0; e < 8; ++e) {
                            const float r_ = (float)(((e < 4 ? gr.x : gr.y) >> (8 * (e & 3))) & 0xffu), a_ = (float)(((e < 4 ? ga.x : ga.y) >> (8 * (e & 3))) & 0xffu);
                            acc[ai][bj][m][e >> 2][e & 3] *= r_ * __builtin_amdgcn_rcpf(a_);
                        }
                    }
        } else {
#pragma unroll
            for (int ai = 0; ai < 2; ++ai)
#pragma unroll
                for (int m = 0; m < 4; ++m)
#pragma unroll
                    for (int bj = 0; bj < 2; ++bj) {
                        const size_t r = (size_t)(row0 + ai * HALF + m * 16); const int c0 = u.pn * BM + bj * HALF + wc * 32 + 8 * fq;
                        const u32x2 ga = *(const u32x2*)(GT + r * 2048 + 1024 + c0);
                        float o[8];
#pragma unroll
                        for (int e = 0; e < 8; ++e) o[e] = acc[ai][bj][m][e >> 2][e & 3] * ((float)(((e < 4 ? ga.x : ga.y) >> (8 * (e & 3))) & 0xffu) * (1.f / 255.f));
                        u32x4 w; w.x = cvt_pk_bf16(o[0], o[1]); w.y = cvt_pk_bf16(o[2], o[3]); w.z = cvt_pk_bf16(o[4], o[5]); w.w = cvt_pk_bf16(o[6], o[7]);
                        *(u32x4*)(MG + r * 1024 + c0) = w;
                    }
        }
    }
};
struct EpiOutNorm {
    static constexpr bool PERM = false, AFTER_DRAIN = true, MID = false, KEEP = false;
    const float* x; float* out; float* rowss; unsigned* cnt; const float* gfin;
    __device__ __forceinline__ void fused(f32x4 (&acc)[2][2][4][2], const Unit& u, int wr, int wc, int fr, int fq, PG8_LAS unsigned char* lds, int wid, int lane) const {
#pragma unroll
        for (int ai = 0; ai < 2; ++ai)
#pragma unroll
            for (int m = 0; m < 4; ++m) {
                const int r = u.pm * BM + ai * HALF + wr * 64 + m * 16 + fr; float ss = 0.f;
#pragma unroll
                for (int bj = 0; bj < 2; ++bj)
#pragma unroll
                    for (int n = 0; n < 2; ++n) {
                        const size_t off = (size_t)r * 1024 + u.pn * BM + bj * HALF + wc * 32 + n * 16 + 4 * fq;
                        const f32x4 o = *(const f32x4*)(x + off) + acc[ai][bj][m][n];
                        acc[ai][bj][m][n] = o; ss += (o[0] * o[0] + o[1] * o[1]) + (o[2] * o[2] + o[3] * o[3]);
                    }
                ss += __shfl_xor(ss, 16); ss += __shfl_xor(ss, 32);
                if (fq == 0) atomicAdd(rowss + r, ss);
                if (m == 3) asm volatile("" ::: "memory");
            }
        asm volatile("s_waitcnt vmcnt(0)" ::: "memory");
        __syncthreads();
        if (threadIdx.x == 0) {
            __hip_atomic_fetch_add(cnt + 64 * u.pm, 1u, __ATOMIC_RELEASE, __HIP_MEMORY_SCOPE_AGENT);
            unsigned spins = 0;
            while (__hip_atomic_load(cnt + 64 * u.pm, __ATOMIC_ACQUIRE, __HIP_MEMORY_SCOPE_AGENT) < 4u) { __builtin_amdgcn_s_sleep(2); if (++spins > (1u << 22)) break; }
        }
        __syncthreads();
        f32x4 gf[2][2];
#pragma unroll
        for (int bj = 0; bj < 2; ++bj)
#pragma unroll
            for (int n = 0; n < 2; ++n) gf[bj][n] = *(const f32x4*)(gfin + u.pn * BM + bj * HALF + wc * 32 + n * 16 + 4 * fq);
        float ssr[8];
#pragma unroll
        for (int k = 0; k < 8; ++k) ssr[k] = __hip_atomic_load(rowss + u.pm * BM + (k >> 2) * HALF + wr * 64 + (k & 3) * 16 + fr, __ATOMIC_RELAXED, __HIP_MEMORY_SCOPE_AGENT);
#pragma unroll
        for (int ai = 0; ai < 2; ++ai)
#pragma unroll
            for (int m = 0; m < 4; ++m) {
                const int r = u.pm * BM + ai * HALF + wr * 64 + m * 16 + fr;
                const float sc = 1.f / sqrtf(ssr[ai * 4 + m] * (1.f / 1024.f) + 1e-6f);
#pragma unroll
                for (int bj = 0; bj < 2; ++bj)
#pragma unroll
                    for (int n = 0; n < 2; ++n) {
                        const int col = u.pn * BM + bj * HALF + wc * 32 + n * 16 + 4 * fq;
                        *(f32x4*)(out + (size_t)r * 1024 + col) = acc[ai][bj][m][n] * sc * gf[bj][n];
                    }
            }
    }
};
}

__device__ __forceinline__ void p0_transpose_item(const float* W, int N, bf16* WT, int ldo, int koff, LAS float* scr, int item, int lane) {
    const int nblk = N / 32, kb = item / nblk, nb = item % nblk, k0 = 64 * kb, n0 = 32 * nb;
    float wv[32];
#pragma unroll
    for (int i = 0; i < 32; ++i) wv[i] = W[(size_t)(k0 + 2 * i + (lane >> 5)) * N + n0 + (lane & 31)];
#pragma unroll
    for (int i = 0; i < 32; ++i) scr[(2 * i + (lane >> 5)) * 33 + (lane & 31)] = wv[i];
    asm volatile("s_waitcnt lgkmcnt(0)" ::: "memory");
    const int c = lane & 7;
#pragma unroll
    for (int j = 0; j < 4; ++j) { const int n = (lane >> 3) + 8 * j; const LAS float* s = scr + (8 * c) * 33 + n;
        u32x4 o; o.x = pk2(s[0 * 33], s[1 * 33]); o.y = pk2(s[2 * 33], s[3 * 33]); o.z = pk2(s[4 * 33], s[5 * 33]); o.w = pk2(s[6 * 33], s[7 * 33]);
        *(u32x4*)(WT + (size_t)(n0 + n) * ldo + koff + k0 + 8 * c) = o; }
    asm volatile("s_waitcnt lgkmcnt(0)" ::: "memory");
}
__device__ __forceinline__ void p0_prologue(const Args& a, LAS unsigned char* lds, int tid, int wave, int lane) {
    unsigned char* ws = a.ws;
    LAS float* scr = (LAS float*)(lds + wave * 16384);
    const int gw = blockIdx.x * 8 + wave, NGW = gridDim.x * 8;
    constexpr int I_IN = (DM / 64) * (INC / 32), I_BR = (RW / 64) * (DM / 32), I_O = (DM / 64) * (DM / 32);
    constexpr int NITEMS = I_IN + 2 * I_BR + I_O;
    for (int it = gw; it < NITEMS; it += NGW) {
        int r = it;
        if (r < I_IN) { p0_transpose_item(a.in[I_WIN], INC, (bf16*)(ws + WS_WIN), DM, 0, scr, r, lane); continue; } r -= I_IN;
        if (r < I_BR) { p0_transpose_item(a.in[I_WBR], DM, (bf16*)(ws + WS_WBR), DM, 0, scr, r, lane); continue; } r -= I_BR;
        if (r < I_BR) { p0_transpose_item(a.in[I_WBA], DM, (bf16*)(ws + WS_WBR), DM, RW, scr, r, lane); continue; } r -= I_BR;
        p0_transpose_item(a.in[I_WOUT], DM, (bf16*)(ws + WS_WOUT), DM, 0, scr, r, lane);
    }
    { const int gt = blockIdx.x * NT + tid, GT_ = gridDim.x * NT;
      u32x4* wp = (u32x4*)((bf16*)(ws + WS_WIN) + (size_t)INC * DM);
      for (int i = gt; i < (INCP - INC) * DM / 8; i += GT_) wp[i] = (u32x4){0u, 0u, 0u, 0u};
      float* rs = (float*)(ws + WS_ROWSS);
      for (int i = gt; i < M; i += GT_) rs[i] = 0.f;
      unsigned* pc = (unsigned*)(ws + WS_PCNT);
      for (int i = gt; i < 64 * 64; i += GT_) pc[i] = 0u; }
    const float* gp = a.in[I_GPRE];
    f32x4 gv[4];
#pragma unroll
    for (int j = 0; j < 4; ++j) gv[j] = ((const f32x4*)gp)[lane + 64 * j];
    for (int m = gw; m < M; m += 2 * NGW) {
        const f32x4* xr0 = (const f32x4*)(a.in[I_X] + (size_t)m * DM) + lane; const f32x4* xr1 = xr0 + (size_t)NGW * (DM / 4);
        f32x4 v0[4], v1[4]; float s0 = 0.f, s1 = 0.f;
#pragma unroll
        for (int j = 0; j < 4; ++j) { v0[j] = xr0[64 * j]; v1[j] = xr1[64 * j]; }
#pragma unroll
        for (int j = 0; j < 4; ++j) { s0 += (v0[j].x * v0[j].x + v0[j].y * v0[j].y) + (v0[j].z * v0[j].z + v0[j].w * v0[j].w); s1 += (v1[j].x * v1[j].x + v1[j].y * v1[j].y) + (v1[j].z * v1[j].z + v1[j].w * v1[j].w); }
        const float sc0 = 1.f / sqrtf(wave_sum(s0) * (1.f / DM) + 1e-6f), sc1 = 1.f / sqrtf(wave_sum(s1) * (1.f / DM) + 1e-6f);
        unsigned long long* o0 = (unsigned long long*)((bf16*)(ws + WS_HB) + (size_t)m * DM) + lane; unsigned long long* o1 = o0 + (size_t)NGW * (DM / 4);
#pragma unroll
        for (int j = 0; j < 4; ++j) { const f32x4 y0 = v0[j] * sc0 * gv[j], y1 = v1[j] * sc1 * gv[j];
            o0[64 * j] = (unsigned long long)pk2(y0.x, y0.y) | ((unsigned long long)pk2(y0.z, y0.w) << 32); o1[64 * j] = (unsigned long long)pk2(y1.x, y1.y) | ((unsigned long long)pk2(y1.z, y1.w) << 32); }
    }
}

__device__ __forceinline__ void attn_item(LAS unsigned char* lds, const Args& a, int b, int qb, int kvh, int tid, int wave, int lane, int dry) {
    LAS bf16* Ks = (LAS bf16*)lds;
    LAS bf16* Vt = (LAS bf16*)(lds + 36864);
    const bf16* QKV = (const bf16*)(a.ws + WS_QKV);
    bf16* G = (bf16*)(a.ws + WS_G);
    const long m0 = (long)b * SEQ + qb * 128;
    const int g = wave >> 1, qh = wave & 1, head = kvh * 4 + g;
    const int r = lane & 31, h = lane >> 5;
    u32x4 kv[4], vv[4];
#pragma unroll
    for (int i = 0; i < 4; ++i) {
        const int c = tid + i * NT, key = c >> 3, d8 = (c & 7) * 8; const long row = m0 - 128 + key;
        kv[i] = (u32x4){0u, 0u, 0u, 0u}; vv[i] = (u32x4){0u, 0u, 0u, 0u};
        if (qb > 0 || key >= 128) { kv[i] = *(const u32x4*)(QKV + row * QKVW + 512 + kvh * 64 + d8); vv[i] = *(const u32x4*)(QKV + row * QKVW + 640 + kvh * 64 + d8); }
    }
    bf16x8 qf[2][4];
#pragma unroll
    for (int s = 0; s < 4; ++s) qf[0][s] = *(const bf16x8*)(QKV + (m0 + qh * 64 + r) * QKVW + head * 64 + 8 * h + 16 * s);
#pragma unroll
    for (int i = 0; i < 4; ++i) {
        const int c = tid + i * NT, key = c >> 3, d8 = (c & 7) * 8;
        *(LAS u32x4*)(Ks + key * 72 + d8) = kv[i];
#pragma unroll
        for (int e = 0; e < 4; ++e) { const unsigned w = e == 0 ? vv[i].x : e == 1 ? vv[i].y : e == 2 ? vv[i].z : vv[i].w; Vt[(d8 + 2 * e) * 264 + key] = (bf16)(w & 0xffffu); Vt[(d8 + 2 * e + 1) * 264 + key] = (bf16)(w >> 16); }
    }
    __syncthreads();
    const float sink = a.in[I_SINKS][head];
#pragma unroll
    for (int qt = 0; qt < 2; ++qt) {
        const int q0 = qh * 64 + qt * 32, kt0 = q0 >> 5, qi = q0 + r;
        bf16* gp = G + (m0 + qi) * 1024 + 512 + head * 64;
        bf16* op = (dry & 1) ? (bf16*)(a.ws + 38 * MiB) + ((m0 + qi) & 4095) * 1024 + 512 + head * 64 : gp;
        u32x2 gt[8];
#pragma unroll
        for (int e = 0; e < 8; ++e) gt[e] = *(const u32x2*)(gp + (e >> 2) * 32 + 8 * (e & 3) + 4 * h);
        if (qt == 0) {
#pragma unroll
            for (int s = 0; s < 4; ++s) qf[1][s] = *(const bf16x8*)(QKV + (m0 + q0 + 32 + r) * QKVW + head * 64 + 8 * h + 16 * s);
        }
        f32x16 X[5];
#pragma unroll
        for (int kk = 0; kk < 5; ++kk) {
            f32x16 acc;
#pragma unroll
            for (int i = 0; i < 16; ++i) acc[i] = 0.f;
            const LAS bf16* kp = Ks + ((kt0 + kk) * 32 + r) * 72 + 8 * h;
#pragma unroll
            for (int s = 0; s < 4; ++s) { const bf16x8 kf = *(const LAS bf16x8*)(kp + 16 * s); acc = __builtin_amdgcn_mfma_f32_32x32x16_bf16(kf, qf[qt][s], acc, 0, 0, 0); }
            X[kk] = acc;
        }
        float mx = sink;
#pragma unroll
        for (int kk = 0; kk < 5; ++kk)
#pragma unroll
            for (int i = 0; i < 16; ++i) {
                const int kj = (kt0 + kk) * 32 + (i & 3) + 8 * (i >> 2) + 4 * h;
                const bool valid = (kj > qi) && (kj <= qi + 128) && (qb > 0 || kj >= 128);
                const float s = valid ? X[kk][i] : -1e30f; X[kk][i] = s; mx = fmaxf(mx, s);
            }
        mx = fmaxf(mx, __shfl_xor(mx, 32));
        float sum = 0.f;
#pragma unroll
        for (int kk = 0; kk < 5; ++kk)
#pragma unroll
            for (int i = 0; i < 16; ++i) { const float p = __expf(X[kk][i] - mx); X[kk][i] = p; sum += p; }
        sum += __shfl_xor(sum, 32); sum += __expf(sink - mx);
        const float inv = 1.f / sum;
        f32x16 O[2];
#pragma unroll
        for (int i = 0; i < 16; ++i) { O[0][i] = 0.f; O[1][i] = 0.f; }
#pragma unroll
        for (int kk = 0; kk < 5; ++kk)
#pragma unroll
            for (int s = 0; s < 2; ++s) {
                u32x4 pw; pw.x = pk2(X[kk][8 * s + 0], X[kk][8 * s + 1]); pw.y = pk2(X[kk][8 * s + 2], X[kk][8 * s + 3]); pw.z = pk2(X[kk][8 * s + 4], X[kk][8 * s + 5]); pw.w = pk2(X[kk][8 * s + 6], X[kk][8 * s + 7]);
                const bf16x8 pf = __builtin_bit_cast(bf16x8, pw);
#pragma unroll
                for (int dt = 0; dt < 2; ++dt) {
                    const LAS bf16* vp = Vt + (dt * 32 + r) * 264 + (kt0 + kk) * 32 + 16 * s + 4 * h;
                    const u32x2 v0 = *(const LAS u32x2*)vp, v1 = *(const LAS u32x2*)(vp + 8);
                    const u32x4 vw = {v0.x, v0.y, v1.x, v1.y};
                    O[dt] = __builtin_amdgcn_mfma_f32_32x32x16_bf16(__builtin_bit_cast(bf16x8, vw), pf, O[dt], 0, 0, 0);
                }
            }
#pragma unroll
        for (int dt = 0; dt < 2; ++dt)
#pragma unroll
            for (int g4 = 0; g4 < 4; ++g4) {
                const int d = dt * 32 + 8 * g4 + 4 * h;
                const u32x2 gv = gt[dt * 4 + g4];
                u32x2 o; o.x = pk2(O[dt][4 * g4 + 0] * inv * bflo(gv.x), O[dt][4 * g4 + 1] * inv * bfhi(gv.x)); o.y = pk2(O[dt][4 * g4 + 2] * inv * bflo(gv.y), O[dt][4 * g4 + 3] * inv * bfhi(gv.y));
                *(u32x2*)(op + d) = o;
            }
    }
    __syncthreads();
}

#define LBAR() asm volatile("s_waitcnt lgkmcnt(0)\n\ts_barrier" ::: "memory")
constexpr int LD = 65, SLOT = 64 * LD;
constexpr int RW_SMALL = 34176;
__device__ __forceinline__ f32x16 zero16() { f32x16 z;
#pragma unroll
    for (int i = 0; i < 16; ++i) z[i] = 0.f;
    return z; }
template <bool AT, bool BT>
__device__ __forceinline__ f32x16 mm32(const LAS float* A, const LAS float* B, int m0, int n0, int lane, f32x16 acc, int kbeg = 0, int kend = 64) {
    const int i = lane & 31, kh = lane >> 5;
#pragma unroll 8
    for (int k = kbeg; k < kend; k += 2) {
        const float av = AT ? A[(k + kh) * LD + m0 + i] : A[(m0 + i) * LD + k + kh];
        const float bv = BT ? B[(n0 + i) * LD + k + kh] : B[(k + kh) * LD + n0 + i];
        acc = __builtin_amdgcn_mfma_f32_32x32x2f32(av, bv, acc, 0, 0, 0);
    }
    return acc;
}
__device__ __forceinline__ int crow(int i, int h) { return (i & 3) + 8 * (i >> 2) + 4 * h; }
__device__ __forceinline__ float dpp_f(float x, const int ctrl_sel) {
    int v = __builtin_bit_cast(int, x), r;
    if (ctrl_sel == 0) r = __builtin_amdgcn_update_dpp(0, v, 0xB1, 0xF, 0xF, true);
    else if (ctrl_sel == 1) r = __builtin_amdgcn_update_dpp(0, v, 0x4E, 0xF, 0xF, true);
    else r = __builtin_amdgcn_update_dpp(0, v, 0x141, 0xF, 0xF, true);
    return __builtin_bit_cast(float, r);
}
__device__ __forceinline__ float sum8(float x) { x += dpp_f(x, 0); x += dpp_f(x, 1); x += dpp_f(x, 2); return x; }

__device__ __forceinline__ f32x16 mmb_fwd(const LAS bf16* A, const LAS bf16* B, int m0, int n0, int lane, f32x16 acc) {
    const LAS bf16* ap = A + (m0 + (lane & 31)) * 72 + 8 * (lane >> 5); const LAS bf16* bp = B + (n0 + (lane & 31)) * 72 + 8 * (lane >> 5);
#pragma unroll
    for (int s = 0; s < 4; ++s) acc = __builtin_amdgcn_mfma_f32_32x32x16_bf16(*(const LAS bf16x8*)(ap + 16 * s), *(const LAS bf16x8*)(bp + 16 * s), acc, 0, 0, 0);
    return acc;
}
struct RWP { u32x4 du_hi, du_lo, iu_hi, iu_lo; float mu_w, mu_a, mu_r, mu_k, mu_v, kkw, kaw, rkw, w0a0; };
__device__ __forceinline__ void rwp_load(RWP& p, const Args& a, int h, int wave, int lane) {
    const int ch = h * 64 + lane; float wdu[8], wiu[8], lo_[8];
#pragma unroll
    for (int tt = 0; tt < 8; ++tt) { const int i = 8 * wave + tt; wdu[tt] = a.in[I_WDU][(size_t)i * RW + ch]; wiu[tt] = a.in[I_WIU][(size_t)i * RW + ch]; }
#pragma unroll
    for (int tt = 0; tt < 8; ++tt) lo_[tt] = wdu[tt] - bf2f((bf16)f2bf(wdu[tt]));
    p.du_hi = (u32x4){pk2(wdu[0], wdu[1]), pk2(wdu[2], wdu[3]), pk2(wdu[4], wdu[5]), pk2(wdu[6], wdu[7])}; p.du_lo = (u32x4){pk2(lo_[0], lo_[1]), pk2(lo_[2], lo_[3]), pk2(lo_[4], lo_[5]), pk2(lo_[6], lo_[7])};
#pragma unroll
    for (int tt = 0; tt < 8; ++tt) lo_[tt] = wiu[tt] - bf2f((bf16)f2bf(wiu[tt]));
    p.w0a0 = a.in[(wave >> 2) ? I_A0 : I_W0][h * 64 + (wave & 1) * 32 + (lane & 31)];
    { const float* mu = a.in[I_MU]; p.mu_w = mu[1536 + lane]; p.mu_a = mu[1600 + lane]; p.mu_r = mu[ch]; p.mu_k = mu[512 + ch]; p.mu_v = mu[1024 + ch]; p.kkw = a.in[I_KK][ch]; p.kaw = a.in[I_KA][ch]; p.rkw = a.in[I_RK][ch]; }
    p.iu_hi = (u32x4){pk2(wiu[0], wiu[1]), pk2(wiu[2], wiu[3]), pk2(wiu[4], wiu[5]), pk2(wiu[6], wiu[7])}; p.iu_lo = (u32x4){pk2(lo_[0], lo_[1]), pk2(lo_[2], lo_[3]), pk2(lo_[4], lo_[5]), pk2(lo_[6], lo_[7])};
}
template <int MODE>
__device__ __forceinline__ void rw_prep(LAS float* X, const Args& a, int b, int h, int t0, int tid, int wave, int lane, int dry, const RWP& pw) {
    const bf16* SH = (const bf16*)(a.ws + WS_SH);
    const float* mu = a.in[I_MU];
    const int j = lane, ch = h * 64 + j;
    const size_t mrow = (size_t)b * SEQ + t0;
    const bf16* sh = SH + (mrow + 8 * wave) * SHW;
    const bool first = (t0 + 8 * wave == 0);
    LAS float* tot = X + RW_SMALL;
    LAS float* ctl = X + RW_SMALL + 512;
    bf16 rw_[9], ra_[9], rr_[9], rk_[9], rv_[9];
#pragma unroll
    for (int tt = 0; tt < 9; ++tt) {
        const bf16* p = sh + (long)(tt - 1) * SHW;
        const bool z = (tt == 0) && first;
        rw_[tt] = z ? (bf16)0 : p[1536 + j]; ra_[tt] = z ? (bf16)0 : p[1600 + j];
        rr_[tt] = z ? (bf16)0 : p[ch]; rk_[tt] = z ? (bf16)0 : p[512 + ch]; rv_[tt] = z ? (bf16)0 : p[1024 + ch];
    }
    const float mu_w = pw.mu_w, mu_a = pw.mu_a, mu_r = pw.mu_r, mu_k = pw.mu_k, mu_v = pw.mu_v;
    const float kkw = pw.kkw, kaw = pw.kaw, rkw = pw.rkw;
    {
        LAS bf16* Bq = (LAS bf16*)X;
#pragma unroll
        for (int tt = 0; tt < 8; ++tt) {
            const int t = 8 * wave + tt;
            const float pw = bf2f(rw_[tt + 1]), pa = bf2f(ra_[tt + 1]), qw = bf2f(rw_[tt]), qa = bf2f(ra_[tt]);
            const float xw = pw + (qw - pw) * mu_w;
            const float e2 = __expf(2.f * xw);
            Bq[0 * 4608 + t * 72 + j] = (bf16)f2bf(1.f - 2.f * __builtin_amdgcn_rcpf(e2 + 1.f));
            Bq[1 * 4608 + t * 72 + j] = (bf16)f2bf(pa + (qa - pa) * mu_a);
        }
        *(LAS u32x4*)(Bq + 2 * 4608 + j * 72 + 8 * wave) = pw.du_hi; *(LAS u32x4*)(Bq + 3 * 4608 + j * 72 + 8 * wave) = pw.du_lo;
        *(LAS u32x4*)(Bq + 4 * 4608 + j * 72 + 8 * wave) = pw.iu_hi; *(LAS u32x4*)(Bq + 5 * 4608 + j * 72 + 8 * wave) = pw.iu_lo;
    }
    LBAR();
    if (dry & 128) return;
    {
        const int hf = wave >> 2, mt = (wave >> 1) & 1, nt = wave & 1;
        LAS bf16* Bq = (LAS bf16*)X;
        f32x16 acc = mmb_fwd(Bq + hf * 4608, Bq + (2 + 2 * hf) * 4608, mt * 32, nt * 32, lane, zero16());
        acc = mmb_fwd(Bq + hf * 4608, Bq + (3 + 2 * hf) * 4608, mt * 32, nt * 32, lane, acc);
        const int col = nt * 32 + (lane & 31), hh = lane >> 5;
        if (hf == 0) {
            const float w0 = pw.w0a0;
#pragma unroll
            for (int i = 0; i < 16; ++i) {
                const float z = -(w0 + acc[i]);
                const float sp = z > 20.f ? z : __logf(1.f + __expf(z));
                X[4 * SLOT + (mt * 32 + crow(i, hh)) * LD + col] = -__expf(-sp - 0.5f);
            }
        } else {
            const float a0 = pw.w0a0;
#pragma unroll
            for (int i = 0; i < 16; ++i) X[5 * SLOT + (mt * 32 + crow(i, hh)) * LD + col] = __builtin_amdgcn_rcpf(1.f + __expf(-(a0 + acc[i])));
        }
    }
    LBAR();
    if (dry & 256) return;
    {
        float ldv[8], cs[8]; float run = 0.f;
#pragma unroll
        for (int tt = 0; tt < 8; ++tt) { ldv[tt] = X[4 * SLOT + (8 * wave + tt) * LD + j]; run += ldv[tt]; cs[tt] = run; }
        tot[wave * 64 + j] = run;
        LBAR();
        float off = 0.f, gC = 0.f;
#pragma unroll
        for (int w2 = 0; w2 < 8; ++w2) { const float v = tot[w2 * 64 + j]; off += (w2 < wave) ? v : 0.f; gC += v; }
        float tq[4][8]; float ctv = 0.f;
        float rr8[8], kkv8[8], km8[8], vx8[8], av8[8], xs[16];
#pragma unroll
        for (int tt = 0; tt < 8; ++tt) {
            const int t = 8 * wave + tt;
            const float r1 = bf2f(rr_[tt + 1]), k1 = bf2f(rk_[tt + 1]), v1 = bf2f(rv_[tt + 1]), r0 = bf2f(rr_[tt]), k0 = bf2f(rk_[tt]), v0 = bf2f(rv_[tt]);
            const float rr = r1 + (r0 - r1) * mu_r, kx = k1 + (k0 - k1) * mu_k;
            vx8[tt] = v1 + (v0 - v1) * mu_v;
            const float av = X[5 * SLOT + t * LD + j];
            const float kkv = kx * kkw, km = kx * (1.f + (av - 1.f) * kaw);
            rr8[tt] = rr; kkv8[tt] = kkv; km8[tt] = km; av8[tt] = av;
            xs[2 * tt] = kkv * kkv; xs[2 * tt + 1] = rr * km * rkw;
        }
        float tot16[16];
        {
            const bool b0 = (lane & 1) != 0, b1 = (lane & 2) != 0, b2 = (lane & 4) != 0, b3 = (lane & 8) != 0;
            float y[8], z[4], w2[2], u;
#pragma unroll
            for (int i = 0; i < 8; ++i) { const float lo = xs[i], hi = xs[i + 8]; y[i] = (b0 ? hi : lo) + dppx(b0 ? lo : hi, 0); }
#pragma unroll
            for (int i = 0; i < 4; ++i) { const float lo = y[i], hi = y[i + 4]; z[i] = (b1 ? hi : lo) + dppx(b1 ? lo : hi, 1); }
#pragma unroll
            for (int i = 0; i < 2; ++i) { const float lo = z[i], hi = z[i + 2]; w2[i] = (b2 ? hi : lo) + __builtin_bit_cast(float, __builtin_amdgcn_ds_swizzle(__builtin_bit_cast(int, b2 ? lo : hi), 0x101F)); }
            { const float lo = w2[0], hi = w2[1]; u = (b3 ? hi : lo) + __builtin_bit_cast(float, __builtin_amdgcn_ds_swizzle(__builtin_bit_cast(int, b3 ? lo : hi), 0x201F)); }
            u += __builtin_bit_cast(float, __builtin_amdgcn_ds_swizzle(__builtin_bit_cast(int, u), 0x401F));
            u += __shfl_xor(u, 32);
            const int iu = __builtin_bit_cast(int, u);
#pragma unroll
            for (int q = 0; q < 16; ++q) tot16[q] = __builtin_bit_cast(float, __builtin_amdgcn_readlane(iu, ((q >> 3) & 1) + 2 * ((q >> 2) & 1) + 4 * ((q >> 1) & 1) + 8 * (q & 1)));
        }
#pragma unroll
        for (int tt = 0; tt < 8; ++tt) {
            const int t = 8 * wave + tt;
            const float rr = rr8[tt], kkv = kkv8[tt], km = km8[tt], vx = vx8[tt], av = av8[tt];
            const float n2 = tot16[2 * tt], ct = tot16[2 * tt + 1];
            const float kap = kkv * __builtin_amdgcn_rsqf(fmaxf(n2, 1e-24f));
            const float be = kap * av;
            ctv = (lane == tt) ? ct : ctv;
            const float g = off + cs[tt];
            const float eg = __expf(g), egx = __expf(g - ldv[tt]), ieg = __expf(-g), ec = __expf(gC - g);
            LAS bf16* Bq = (LAS bf16*)X;
            Bq[0 * 4608 + t * 72 + j] = (bf16)f2bf(rr * eg); Bq[1 * 4608 + t * 72 + j] = (bf16)f2bf(kap * egx); Bq[3 * 4608 + t * 72 + j] = (bf16)f2bf(km * ieg); Bq[4 * 4608 + t * 72 + j] = (bf16)f2bf(be * ieg);
            tq[0][tt] = kap * egx; tq[1][tt] = vx; tq[2][tt] = km * ec; tq[3][tt] = be * ec;
        }
        if (lane < 8) { ctl[8 * wave + lane] = ctv; ((float*)(a.ws + WS_CT))[(mrow + 8 * wave + lane) * 8 + h] = ctv; }
        {
            LAS bf16* Bq = (LAS bf16*)X;
#pragma unroll
            for (int q = 0; q < 4; ++q) {
                u32x4 w; w.x = pk2(tq[q][0], tq[q][1]); w.y = pk2(tq[q][2], tq[q][3]); w.z = pk2(tq[q][4], tq[q][5]); w.w = pk2(tq[q][6], tq[q][7]);
                const int slot = q == 0 ? 2 * 4608 : q == 1 ? 5 * 4608 : q == 2 ? 6 * 4608 : 49920;
                *(LAS u32x4*)(Bq + slot + j * 72 + 8 * wave) = w;
            }
        }
        if (wave == 0) X[RW_SMALL + 576 + j] = __expf(gC);
    }
    LBAR();
}
__device__ __forceinline__ void rw_post(LAS float* X, const Args& a, int b, int h, int t0, int wave, int lane, const bf16 (&gt)[8], const float gw, const float gb, int dry) {
    bf16* G = (bf16*)(a.ws + WS_G);
    LAS float* ctl = X + RW_SMALL + 512;
    const int ch = h * 64 + lane;
    bf16* gp = G + ((size_t)b * SEQ + t0 + 8 * wave) * 1024 + ch;
    bf16* op = (dry & 1) ? (bf16*)(a.ws + 38 * MiB) + ((t0 + 8 * wave) & 4095) * 1024 + ch : gp;
#pragma unroll
    for (int tt = 0; tt < 8; ++tt) {
        const int t = 8 * wave + tt;
        const float y = X[5 * SLOT + t * LD + lane];
        const float mean = wave_sum(y) * (1.f / 64.f); const float d = y - mean;
        const float var = wave_sum(d * d) * (1.f / 64.f);
        const float o = d * __builtin_amdgcn_rsqf(var + 64e-5f) * gw + gb + ctl[t] * X[4 * SLOT + t * LD + lane];
        op[tt * 1024] = (bf16)f2bf(o * bf2f(gt[tt]));
    }
}
__device__ __forceinline__ unsigned pf_rw1(const Args& a, int item, int tid) {
    if (item >= 2048 || tid >= 325) return 0u;
    const int bh = item >> 7, c = item & 127, b = bh >> 3, h = bh & 7;
    const long m = (long)b * SEQ + c * 64 - 1 + tid / 5; const int sg = tid % 5;
    if (m < 0) return 0u;
    const int col = sg < 3 ? sg * 512 + h * 64 : 1536 + (sg - 3) * 64;
    return *(const unsigned*)((const bf16*)(a.ws + WS_SH) + m * SHW + col);
}
__device__ __forceinline__ unsigned pf_rw3(const Args& a, int item, int tid) {
    if (item >= 2048) return 0u;
    const int bh = item >> 7, c = item & 127, b = bh >> 3, h = bh & 7;
    const long mrow = (long)b * SEQ + c * 64;
    unsigned r = 0u;
    if (tid < 192) { const int w = tid >> 6, l = tid & 63;
        const char* p = w == 0 ? (const char*)((const bf16*)(a.ws + WS_SL) + (size_t)(item > 0 ? item - 1 : 0) * 4096) : w == 1 ? (const char*)((const bf16*)(a.ws + WS_YL) + (size_t)item * 4096) : (const char*)((const bf16*)(a.ws + WS_PY) + (size_t)item * 4096);
        r = *(const unsigned*)(p + l * 128); }
    else if (tid < 384) { }
    else { const int l = tid - 384;
        const long m = mrow + (l & 63);
        r = (l < 64) ? *(const unsigned*)((const bf16*)(a.ws + WS_G) + m * 1024 + h * 64) : *(const unsigned*)((const bf16*)(a.ws + WS_SH) + m * SHW + 1024 + h * 64); }
    return r;
}
__device__ __forceinline__ void pf_sink(const Args& a, unsigned v) { if (v == 0xDEADBEEFu) *(unsigned*)(a.ws + WS_DUMMY) = v; }

constexpr int BIMG = 4608;
constexpr int L_RT = 0, L_KT = BIMG, L_KTT = 2 * BIMG, L_KH = 3 * BIMG, L_BH = 4 * BIMG, L_VT = 5 * BIMG, L_KBT = 6 * BIMG;
constexpr int H_BBT = 49920, H_ABRT = 49920 + BIMG, H_AKK = 49920 + 2 * BIMG, H_TT = 49920 + 3 * BIMG;
constexpr int L_W1 = L_KH, L_W2 = L_BH, H_QYT = H_AKK, H_QST = H_TT;
__device__ __forceinline__ f32x16 mmb(const LAS bf16* A, const LAS bf16* B, int m0, int n0, int lane, f32x16 acc) {
    const LAS bf16* ap = A + (m0 + (lane & 31)) * 72 + 8 * (lane >> 5); const LAS bf16* bp = B + (n0 + (lane & 31)) * 72 + 8 * (lane >> 5);
#pragma unroll
    for (int s = 0; s < 4; ++s) acc = __builtin_amdgcn_mfma_f32_32x32x16_bf16(*(const LAS bf16x8*)(ap + 16 * s), *(const LAS bf16x8*)(bp + 16 * s), acc, 0, 0, 0);
    return acc;
}
__device__ __forceinline__ void st_t_lds(LAS bf16* dst, const f32x16& v, int m0, int col, int hh) {
#pragma unroll
    for (int g4 = 0; g4 < 4; ++g4) { u32x2 w; w.x = pk2(v[4 * g4], v[4 * g4 + 1]); w.y = pk2(v[4 * g4 + 2], v[4 * g4 + 3]); *(LAS u32x2*)(dst + col * 72 + m0 + 8 * g4 + 4 * hh) = w; }
}
__device__ __forceinline__ void st_t_glb(bf16* dst, const f32x16& v, int m0, int col, int hh) {
#pragma unroll
    for (int g4 = 0; g4 < 4; ++g4) { u32x2 w; w.x = pk2(v[4 * g4], v[4 * g4 + 1]); w.y = pk2(v[4 * g4 + 2], v[4 * g4 + 3]); *(u32x2*)(dst + col * 64 + m0 + 8 * g4 + 4 * hh) = w; }
}
__device__ __forceinline__ void rw1b_item(LAS float* X, const Args& a, int item, int tid, int wave, int lane, int dry, const RWP& pw) {
    const int bh = item >> 7, c = item & 127, b = bh >> 3, h = bh & 7;
    rw_prep<2>(X, a, b, h, c * 64, tid, wave, lane, dry, pw);
    if (dry & (16 | 128 | 256)) return;
    LAS bf16* Bq = (LAS bf16*)X; LAS float* XT = X + 4 * SLOT;
    const int hf = wave >> 2, m0 = ((wave >> 1) & 1) * 32, n0 = (wave & 1) * 32; int col = n0 + (lane & 31), hh = lane >> 5;
    asm volatile("" : "+v"(col), "+v"(hh));
    f32x16 acc1 = hf ? mmb(Bq + L_KT, Bq + L_KH, m0, n0, lane, zero16()) : mmb(Bq + L_BH, Bq + L_KT, m0, n0, lane, zero16());
    f32x16 acc2 = mmb(Bq + (hf ? L_KH : L_BH), Bq + L_RT, m0, n0, lane, zero16());
#pragma unroll
    for (int i = 0; i < 16; ++i) {
        const int row = m0 + crow(i, hh);
        acc2[i] = row <= col ? acc2[i] : 0.f;
        if (hf == 0) XT[row * LD + col] = row < col ? acc1[i] : 0.f; else acc1[i] = col < row ? acc1[i] : 0.f;
    }
    if (hf == 0) st_t_lds(Bq + H_ABRT, acc2, m0, col, hh); else st_t_lds(Bq + H_AKK, acc1, m0, col, hh);
    LBAR();
    if (!(dry & 32)) {
        const int lr = lane & 15, lq = lane >> 4;
        if (wave == 0) {
            int ii = lr; asm volatile("" : "+v"(ii)); const int base = lq * 16;
            float Tr[16];
#pragma unroll
            for (int t = 0; t < 16; ++t) {
                float s = (t == ii) ? 1.f : 0.f;
#pragma unroll
                for (int j = 0; j < t; ++j) s -= Tr[j] * XT[(base + j) * LD + base + t];
                Tr[t] = s;
            }
#pragma unroll
            for (int t = 0; t < 16; ++t) XT[(base + ii) * LD + base + t] = Tr[t];
        }
        LBAR();
        if (wave < 2) {
            const int base = 32 * wave;
            f32x4 x = {0.f, 0.f, 0.f, 0.f};
            float oa[4], ob[4];
#pragma unroll
            for (int s = 0; s < 4; ++s) { oa[s] = XT[(base + lr) * LD + base + 16 + 4 * s + lq]; ob[s] = XT[(base + 16 + 4 * s + lq) * LD + base + 16 + lr]; }
#pragma unroll
            for (int s = 0; s < 4; ++s) x = __builtin_amdgcn_mfma_f32_16x16x4f32(oa[s], ob[s], x, 0, 0, 0);
#pragma unroll
            for (int r = 0; r < 4; ++r) XT[(base + 4 * lq + r) * LD + base + 16 + lr] = x[r];
            f32x4 y = {0.f, 0.f, 0.f, 0.f};
#pragma unroll
            for (int s = 0; s < 4; ++s) { oa[s] = XT[(base + lr) * LD + base + 4 * s + lq]; ob[s] = XT[(base + 4 * s + lq) * LD + base + 16 + lr]; }
#pragma unroll
            for (int s = 0; s < 4; ++s) y = __builtin_amdgcn_mfma_f32_16x16x4f32(oa[s], ob[s], y, 0, 0, 0);
#pragma unroll
            for (int r = 0; r < 4; ++r) XT[(base + 4 * lq + r) * LD + base + 16 + lr] = -y[r];
        }
        LBAR();
        LAS float* XS = X + 5 * SLOT;
        const int tm = (wave >> 1) & 1, tn = wave & 1;
        if (wave < 4) {
            f32x4 x = {0.f, 0.f, 0.f, 0.f};
            float oa[8], ob[8];
#pragma unroll
            for (int s = 0; s < 8; ++s) { oa[s] = XT[(16 * tm + lr) * LD + 32 + 4 * s + lq]; ob[s] = XT[(32 + 4 * s + lq) * LD + 32 + 16 * tn + lr]; }
#pragma unroll
            for (int s = 0; s < 8; ++s) x = __builtin_amdgcn_mfma_f32_16x16x4f32(oa[s], ob[s], x, 0, 0, 0);
#pragma unroll
            for (int r = 0; r < 4; ++r) XS[(16 * tm + 4 * lq + r) * LD + 16 * tn + lr] = x[r];
        }
        LBAR();
        if (wave < 4) {
            f32x4 y = {0.f, 0.f, 0.f, 0.f};
            float oa[8], ob[8];
#pragma unroll
            for (int s = 0; s < 8; ++s) { oa[s] = XT[(16 * tm + lr) * LD + 4 * s + lq]; ob[s] = XS[(4 * s + lq) * LD + 16 * tn + lr]; }
#pragma unroll
            for (int s = 0; s < 8; ++s) y = __builtin_amdgcn_mfma_f32_16x16x4f32(oa[s], ob[s], y, 0, 0, 0);
#pragma unroll
            for (int r = 0; r < 4; ++r) XT[(16 * tm + 4 * lq + r) * LD + 32 + 16 * tn + lr] = -y[r];
        }
    }
    LBAR();
    {
        const int t = tid >> 3, jb = (tid & 7) * 8; float v[8];
#pragma unroll
        for (int e = 0; e < 8; ++e) v[e] = XT[(jb + e) * LD + t];
        u32x4 w; w.x = pk2(v[0], v[1]); w.y = pk2(v[2], v[3]); w.z = pk2(v[4], v[5]); w.w = pk2(v[6], v[7]);
        *(LAS u32x4*)(Bq + H_TT + t * 72 + jb) = w;
    }
    LBAR();
    if (dry & 64) return;
    acc1 = mmb(Bq + H_TT, Bq + (hf ? H_AKK : L_KTT), m0, n0, lane, zero16());
    st_t_lds(Bq + (hf ? L_W2 : L_W1), acc1, m0, col, hh);
    LBAR();
    acc1 = mmb(Bq + (hf ? L_W2 : L_W1), Bq + H_ABRT, m0, n0, lane, zero16());
    if (hf == 0) {
#pragma unroll
        for (int g4 = 0; g4 < 4; ++g4) { const u32x2 rv = *(const LAS u32x2*)(Bq + L_RT + col * 72 + m0 + 8 * g4 + 4 * hh);
            acc1[4 * g4] = bflo(rv.x) - acc1[4 * g4]; acc1[4 * g4 + 1] = bfhi(rv.x) - acc1[4 * g4 + 1]; acc1[4 * g4 + 2] = bflo(rv.y) - acc1[4 * g4 + 2]; acc1[4 * g4 + 3] = bfhi(rv.y) - acc1[4 * g4 + 3]; }
        st_t_glb((bf16*)(a.ws + WS_PY) + (size_t)item * 4096, acc1, m0, col, hh);
    } else {
#pragma unroll
        for (int i = 0; i < 16; ++i) acc1[i] = acc2[i] - acc1[i];
        st_t_lds(Bq + H_QYT, acc1, m0, col, hh);
    }
    LBAR();
    acc1 = mmb(Bq + (hf ? L_W2 : L_W1), Bq + H_BBT, m0, n0, lane, zero16());
    if (hf == 0) {
        const float gc = X[RW_SMALL + 576 + col];
#pragma unroll
        for (int i = 0; i < 16; ++i) acc1[i] = ((m0 + crow(i, hh)) == col ? gc : 0.f) - acc1[i];
        st_t_glb((bf16*)(a.ws + WS_PS) + (size_t)item * 4096, acc1, m0, col, hh);
    } else {
#pragma unroll
        for (int g4 = 0; g4 < 4; ++g4) { const u32x2 rv = *(const LAS u32x2*)(Bq + L_KBT + col * 72 + m0 + 8 * g4 + 4 * hh);
            acc1[4 * g4] = bflo(rv.x) - acc1[4 * g4]; acc1[4 * g4 + 1] = bfhi(rv.x) - acc1[4 * g4 + 1]; acc1[4 * g4 + 2] = bflo(rv.y) - acc1[4 * g4 + 2]; acc1[4 * g4 + 3] = bfhi(rv.y) - acc1[4 * g4 + 3]; }
        st_t_lds(Bq + H_QST, acc1, m0, col, hh);
    }
    LBAR();
    acc1 = mmb(Bq + L_VT, Bq + (hf ? H_QST : H_QYT), m0, n0, lane, zero16());
    if (hf == 0) st_t_glb((bf16*)(a.ws + WS_YL) + (size_t)item * 4096, acc1, m0, col, hh);
    else { bf16* o = (bf16*)(a.ws + WS_SL) + (size_t)item * 4096;
#pragma unroll
        for (int g4 = 0; g4 < 4; ++g4) { const int row = m0 + 8 * g4 + 4 * hh;
            u32x2 w; w.x = pk2(acc1[4 * g4], acc1[4 * g4 + 1]); w.y = pk2(acc1[4 * g4 + 2], acc1[4 * g4 + 3]);
            *(u32x2*)(o + ((((row >> 4) * 4 + (col >> 4)) * 64 + ((row >> 2) & 3) * 16 + (col & 15)) << 2)) = w; } }
    LBAR();
}
__device__ __forceinline__ void rw2b_scan(LAS float* X, const Args& a, int id, int tid, int wave, int lane, int dry) {
    const int bh = id >> 2, rg = id & 3;
    const bf16* PS = (const bf16*)(a.ws + WS_PS) + (size_t)bh * 128 * 4096;
    bf16* SL = (bf16*)(a.ws + WS_SL) + (size_t)bh * 128 * 4096;
    bf16* SLo = (dry & 1) ? (bf16*)(a.ws + 38 * MiB) + (size_t)(bh & 3) * 128 * 4096 : SL;
    LAS bf16* Sb = (LAS bf16*)X;
    for (int i = tid; i < 2 * 16 * 72 / 2; i += NT) ((LAS unsigned*)X)[i] = 0u;
    __syncthreads();
    const int n = wave & 3, lr = lane & 15, lq = lane >> 4;
    constexpr int D = 8;
    if (wave < 4) {
        bf16x8 pbv[D][2]; u32x2 iniv[D];
        const bf16* pbase = PS + (16 * n + lr) * 64 + 8 * lq;
        const size_t ioff = (size_t)((rg * 4 + n) * 64 + lane) * 4;
#pragma unroll
        for (int d = 0; d < D; ++d) { pbv[d][0] = *(const bf16x8*)(pbase + (size_t)d * 4096); pbv[d][1] = *(const bf16x8*)(pbase + (size_t)d * 4096 + 32); iniv[d] = *(const u32x2*)(SL + (size_t)d * 4096 + ioff); }
        for (int c0 = 0; c0 < NCHUNK; c0 += D) {
#pragma unroll
            for (int d = 0; d < D; ++d) {
                const int c = c0 + d;
                const LAS bf16* Sc = Sb + (d & 1) * 16 * 72; LAS bf16* Sn = Sb + ((d + 1) & 1) * 16 * 72;
                const bf16x8 a0 = *(const LAS bf16x8*)(Sc + lr * 72 + 8 * lq), a1 = *(const LAS bf16x8*)(Sc + lr * 72 + 32 + 8 * lq);
                f32x4 acc = {bflo(iniv[d].x), bfhi(iniv[d].x), bflo(iniv[d].y), bfhi(iniv[d].y)};
                acc = __builtin_amdgcn_mfma_f32_16x16x32_bf16(a0, pbv[d][0], acc, 0, 0, 0);
                acc = __builtin_amdgcn_mfma_f32_16x16x32_bf16(a1, pbv[d][1], acc, 0, 0, 0);
                u32x2 w; w.x = pk2(acc[0], acc[1]); w.y = pk2(acc[2], acc[3]);
                Sn[(4 * lq + 0) * 72 + 16 * n + lr] = (bf16)(w.x & 0xffffu); Sn[(4 * lq + 1) * 72 + 16 * n + lr] = (bf16)(w.x >> 16);
                Sn[(4 * lq + 2) * 72 + 16 * n + lr] = (bf16)(w.y & 0xffffu); Sn[(4 * lq + 3) * 72 + 16 * n + lr] = (bf16)(w.y >> 16);
                *(u32x2*)(SLo + (size_t)c * 4096 + ioff) = w;
                const int cn = c + D < NCHUNK ? c + D : NCHUNK - 1;
                pbv[d][0] = *(const bf16x8*)(pbase + (size_t)cn * 4096); pbv[d][1] = *(const bf16x8*)(pbase + (size_t)cn * 4096 + 32); iniv[d] = *(const u32x2*)(SL + (size_t)cn * 4096 + ioff);
                __syncthreads();
            }
        }
    } else {
        for (int c = 0; c < NCHUNK; ++c) __syncthreads();
    }
}
struct R3 { u32x4 s; u32x4 py; bf16 rv[9]; float ct, mu, gw, gb; u32x4 yl; bf16 gt[8]; };
__device__ __forceinline__ void rw3_load(R3& r, const Args& a, int item, int tid, int wave, int lane) {
    const int bh = item >> 7, c = item & 127, b = bh >> 3, h = bh & 7;
    const bf16* S0 = (const bf16*)(a.ws + WS_SL) + (size_t)(item > 0 ? item - 1 : 0) * 4096;
    const bf16* PY = (const bf16*)(a.ws + WS_PY) + (size_t)item * 4096;
    const bf16* YL = (const bf16*)(a.ws + WS_YL) + (size_t)item * 4096;
    const bf16* SH = (const bf16*)(a.ws + WS_SH);
    const size_t mrow = (size_t)b * SEQ + c * 64;
    const int v = tid >> 3, kb = (tid & 7) * 8, ch = h * 64 + lane;
    r.s = *(const u32x4*)(S0 + 8 * tid); r.yl = *(const u32x4*)(YL + 8 * tid);
    r.py = *(const u32x4*)(PY + v * 64 + kb);
#pragma unroll
    for (int tt = 0; tt < 9; ++tt) r.rv[tt] = (tt == 0 && c == 0 && wave == 0) ? (bf16)0 : SH[(mrow + 8 * wave + tt - 1) * SHW + 1024 + ch];
    r.ct = ((const float*)(a.ws + WS_CT))[(mrow + (tid & 63)) * 8 + h];
    r.mu = a.in[I_MU][1024 + ch]; r.gw = a.in[I_GNW][ch]; r.gb = a.in[I_GNB][ch];
    const bf16* gp = (const bf16*)(a.ws + WS_G) + (mrow + 8 * wave) * 1024 + ch;
#pragma unroll
    for (int tt = 0; tt < 8; ++tt) r.gt[tt] = gp[tt * 1024];
}
__device__ __forceinline__ void rw3_consume(const R3& r, LAS float* X, const Args& a, int item, int tid, int wave, int lane, int dry) {
    const int bh = item >> 7, c = item & 127, b = bh >> 3, h = bh & 7;
    LAS bf16* Bq = (LAS bf16*)X;
#pragma unroll
    for (int q = 0; q < 2; ++q) {
        const int e = 2 * tid + q, rg = e >> 8, n = (e >> 6) & 3, lq = (e >> 4) & 3, lr = e & 15, v0 = 16 * rg + 4 * lq, k = 16 * n + lr;
        const unsigned w0 = c > 0 ? (q ? r.s.z : r.s.x) : 0u, w1 = c > 0 ? (q ? r.s.w : r.s.y) : 0u;
        Bq[(v0 + 0) * 72 + k] = (bf16)(w0 & 0xffffu); Bq[(v0 + 1) * 72 + k] = (bf16)(w0 >> 16); Bq[(v0 + 2) * 72 + k] = (bf16)(w1 & 0xffffu); Bq[(v0 + 3) * 72 + k] = (bf16)(w1 >> 16);
    }
    {
        const int t = tid >> 3, vv = 8 * (tid & 7);
        X[5 * SLOT + t * LD + vv + 0] = bflo(r.yl.x); X[5 * SLOT + t * LD + vv + 1] = bfhi(r.yl.x); X[5 * SLOT + t * LD + vv + 2] = bflo(r.yl.y); X[5 * SLOT + t * LD + vv + 3] = bfhi(r.yl.y);
        X[5 * SLOT + t * LD + vv + 4] = bflo(r.yl.z); X[5 * SLOT + t * LD + vv + 5] = bfhi(r.yl.z); X[5 * SLOT + t * LD + vv + 6] = bflo(r.yl.w); X[5 * SLOT + t * LD + vv + 7] = bfhi(r.yl.w);
    }
    { const int v = tid >> 3, kb = (tid & 7) * 8; *(LAS u32x4*)(Bq + BIMG + v * 72 + kb) = r.py; }
    { const float mu_v = r.mu;
#pragma unroll
      for (int tt = 0; tt < 8; ++tt) { const float v1 = bf2f(r.rv[tt + 1]), v0 = bf2f(r.rv[tt]); X[4 * SLOT + (8 * wave + tt) * LD + lane] = v1 + (v0 - v1) * mu_v; } }
    if (tid < 64) X[RW_SMALL + 512 + tid] = r.ct;
    LBAR();
    if (wave < 4 && !(dry & 1024)) {
        const int m0 = ((wave >> 1) & 1) * 32, n0 = (wave & 1) * 32, col = n0 + (lane & 31), hh = lane >> 5;
        const f32x16 acc = mmb(Bq, Bq + BIMG, m0, n0, lane, zero16());
#pragma unroll
        for (int i = 0; i < 16; ++i) X[5 * SLOT + col * LD + m0 + crow(i, hh)] += acc[i];
    }
    LBAR();
    if (!(dry & 512)) rw_post(X, a, b, h, c * 64, wave, lane, r.gt, r.gw, r.gb, dry);
    LBAR();
}

__device__ __forceinline__ void final_norm(const Args& a, int wave, int lane) {
    const float* rs = (const float*)(a.ws + WS_ROWSS);
    const int gw = blockIdx.x * 8 + wave, NGW = gridDim.x * 8;
    f32x4 gv[4];
#pragma unroll
    for (int j = 0; j < 4; ++j) gv[j] = ((const f32x4*)a.in[I_GFIN])[lane + 64 * j];
    for (int m = gw; m < M; m += NGW) {
        const float sc = 1.f / sqrtf(rs[m] * (1.f / DM) + 1e-6f);
        f32x4* o = (f32x4*)(a.out + (size_t)m * DM) + lane;
#pragma unroll
        for (int j = 0; j < 4; ++j) o[64 * j] = o[64 * j] * sc * gv[j];
    }
}

#define XB_TMO      128
#define XB_XCNT(j)  (256  + 64 * (j))
#define XB_XSUB(j)  (1280 + 64 * (j))
#define XB_XGEN(j)  (2304 + 64 * (j))
#define XB_TOP      3328
#define XB_TOPGEN   3392
#define XCD_BAR_WORDS 3456
#define XB_SPIN_CAP (1u << 18)

__device__ __forceinline__ unsigned xb_ld(unsigned* p)              { return __hip_atomic_load(p, __ATOMIC_RELAXED, __HIP_MEMORY_SCOPE_AGENT); }
__device__ __forceinline__ unsigned xb_add(unsigned* p, unsigned v) { return __hip_atomic_fetch_add(p, v, __ATOMIC_RELAXED, __HIP_MEMORY_SCOPE_AGENT); }
__device__ __forceinline__ unsigned xb_xcc_id() { return (unsigned)__builtin_amdgcn_s_getreg((3 << 11) | 20) & 0xFu; }
#define XB_SPIN(cond, bar) do { unsigned _sp = 0; while (cond) { __builtin_amdgcn_s_sleep(1); \
    if ((++_sp & 255u) == 0u) { if (xb_ld(&(bar)[XB_TMO])) break; if (_sp > XB_SPIN_CAP) { atomicAdd(&(bar)[XB_TMO], 1u); break; } } } } while (0)

struct XcdBarrier {
    unsigned* bar; unsigned x;
    volatile LAS unsigned* st;
};

__device__ __forceinline__ XcdBarrier xcd_barrier_post(unsigned* bar, volatile LAS unsigned* st) {
    XcdBarrier b; b.bar = bar; b.x = xb_xcc_id(); b.st = st;
    if (threadIdx.x == 0) (void)xb_add(&bar[XB_XCNT(b.x)], 1u);
    return b;
}
__device__ __forceinline__ void xcd_barrier_complete(unsigned* bar, unsigned x, unsigned& nloc, unsigned& nx) {
    const unsigned G = gridDim.x * gridDim.y * gridDim.z;
    unsigned sum, cnt, mine, sp = 0u;
    for (;;) {
        sum = 0u; cnt = 0u; mine = 0u;
#pragma unroll
        for (unsigned j = 0; j < 16; ++j) { const unsigned c = xb_ld(&bar[XB_XCNT(j)]); sum += c; cnt += (c > 0u) ? 1u : 0u; mine = (j == x) ? c : mine; }
        if (sum == G) break;
        __builtin_amdgcn_s_sleep(1);
        if ((++sp & 255u) == 0u) { if (xb_ld(&bar[XB_TMO])) break; if (sp > XB_SPIN_CAP) { atomicAdd(&bar[XB_TMO], 1u); break; } }
    }
    nloc = mine > 0u ? mine : 1u; nx = cnt > 0u ? cnt : 1u;
}

__device__ __forceinline__ void xcd_barrier(const XcdBarrier& b) {
    asm volatile("s_waitcnt vmcnt(0)" ::: "memory");
    __syncthreads();
    if (threadIdx.x == 0) {
        unsigned* bar = b.bar;
        __builtin_amdgcn_s_waitcnt(0);
        unsigned nloc = b.st[0], nx = b.st[1];
        if (nloc == 0u) { xcd_barrier_complete(bar, b.x, nloc, nx); b.st[0] = nloc; b.st[1] = nx; }
        const unsigned old = xb_add(&bar[XB_XSUB(b.x)], 1u);
        const unsigned gen = old / nloc;
        if (old + 1u == (gen + 1u) * nloc) {
            __builtin_amdgcn_fence(__ATOMIC_RELEASE, "agent");
            asm volatile("s_waitcnt vmcnt(0)" ::: "memory");
            const unsigned og = xb_add(&bar[XB_TOP], 1u);
            const unsigned tg = og / nx;
            if (og + 1u == (tg + 1u) * nx) xb_add(&bar[XB_TOPGEN], 1u);
            else XB_SPIN(xb_ld(&bar[XB_TOPGEN]) == tg, bar);
            __builtin_amdgcn_fence(__ATOMIC_ACQUIRE, "agent");
            xb_add(&bar[XB_XGEN(b.x)], 1u);
            asm volatile("s_waitcnt vmcnt(0)" ::: "memory");
        } else {
            XB_SPIN(xb_ld(&bar[XB_XGEN(b.x)]) == gen, bar);
            __builtin_amdgcn_fence(__ATOMIC_ACQUIRE, "agent");
            asm volatile("s_waitcnt vmcnt(0)" ::: "memory");
        }
    }
    __syncthreads();
}

#define PROBE_REP_PHASE 0
#define PROBE_REP 0
#define PROBE_LO -1
#define PROBE_HI 0
#define PROBE_N 2
#define PROBE_DRY 0
__global__ void __launch_bounds__(NT, 2) mega(Args a) {
    extern __shared__ __attribute__((aligned(16))) unsigned char lds_raw[];
    LAS unsigned char* lds = (LAS unsigned char*)lds_raw;
    const int tid = threadIdx.x, lane = tid & 63, wave = __builtin_amdgcn_readfirstlane(tid >> 6);
    const int G = gridDim.x, bid = blockIdx.x;
    unsigned char* ws = a.ws;
    cg::grid_group grid = cg::this_grid();
    const int lo = a.ph_lo, hi = a.ph_hi;
#define IN(k) (lo <= (k) && (k) < hi)
#define SEAM(k) do { if (IN(k) && IN((k) + 1)) { if (a.use_xb) xcd_barrier(xbar); else grid.sync(); } } while (0)
    volatile LAS unsigned* xst = (volatile LAS unsigned*)(lds + LDS_BYTES - 64);
    if (tid < 2) xst[tid] = 0u;
    __syncthreads();
    unsigned* xbw = (unsigned*)(ws + WS_BAR);
    XcdBarrier xbar; xbar.bar = xbw; xbar.x = 0; xbar.st = xst;
    if (a.use_xb) xbar = xcd_barrier_post(xbw, xst);
    if (a.ph_hi > 1000) grid.sync();
    if (IN(0)) { p0_prologue(a, lds, tid, wave, lane); }
    SEAM(0);
    if (IN(1)) {
        pg8::Gemm g{(const pg8::bf16_t*)(ws + WS_HB), (const pg8::bf16_t*)(ws + WS_WIN), M, INCP, DM, DM, DM};
        pg8::StaticOrderRev S; S.init(M, INCP, G, bid);
        pg8::EpiIn E{(pg8::bf16_t*)(ws + WS_SH), (pg8::bf16_t*)(ws + WS_G), (pg8::bf16_t*)(ws + WS_QKV), (pg8::bf16_t*)a.out, a.in[I_BQKV]};
        pg8::gemm_phase<pg8::EpiIn, pg8::StaticOrderRev, true, true>(lds, g, S, E);
    }
    SEAM(1);
    const int rp = a.dry >> 16, rn = (a.dry >> 12) & 15; int dry = a.dry & 0xfff;
    if (IN(2)) for (int rep = (rp == 2 ? rn : 0); rep >= 0; --rep) {
        const int ist = G == 256 ? 1 : G, i0 = G == 256 ? bid * 8 : bid, iend = G == 256 ? bid * 8 + 8 : 2048;
        RWP pw; if (G == 256) rwp_load(pw, a, (i0 >> 7) & 7, wave, lane);
        for (int it = i0; it < iend; it += ist) { if (G != 256) rwp_load(pw, a, (it >> 7) & 7, wave, lane);
            const unsigned pf = 0u; rw1b_item((LAS float*)lds, a, it, tid, wave, lane, dry, pw); pf_sink(a, pf); }
    }
    SEAM(2);
    if (IN(3)) {
        const int d3 = dry;
        if (bid < 64) { const int sid = G == 256 ? (bid & 7) * 8 + (bid >> 3) : bid; if (!(d3 & 4)) rw2b_scan((LAS float*)lds, a, sid, tid, wave, lane, d3); }
        else if (!(d3 & 2)) {
            if (G == 256) { const int j = bid - 64, x = j & 7, q = j >> 3;
                { const int it = x * 24 + q; attn_item(lds, a, it >> 7, (it >> 1) & 63, it & 1, tid, wave, lane, d3); }
                if (j < 64) { const int it = 192 + x * 8 + q; attn_item(lds, a, it >> 7, (it >> 1) & 63, it & 1, tid, wave, lane, d3); } }
            else for (int it = bid - 64; it < 256; it += G - 64) attn_item(lds, a, it >> 7, (it >> 1) & 63, it & 1, tid, wave, lane, d3);
        }
    }
    SEAM(3);
    if (IN(4)) for (int rep = (rp == 4 ? rn : 0); rep >= 0; --rep) {
        const int d4 = dry | (rep > 0 ? 1 : 0);
        const int ist = G == 256 ? 1 : G, i0 = G == 256 ? bid * 8 : bid, iend = G == 256 ? bid * 8 + 8 : 2048;
        R3 cur; rw3_load(cur, a, i0, tid, wave, lane);
        for (int it = i0; it < iend; it += ist) {
            const unsigned pf = 0u;
            R3 nxt; rw3_load(nxt, a, it + ist < iend ? it + ist : it, tid, wave, lane);
            rw3_consume(cur, (LAS float*)lds, a, it, tid, wave, lane, d4);
            cur = nxt; pf_sink(a, pf);
        }
    }
    SEAM(4);
    if (IN(5)) {
        pg8::StaticOrderK2 S; S.init(M, DM, G, bid);
        pg8::Gemm g{(const pg8::bf16_t*)(ws + WS_G), (const pg8::bf16_t*)(ws + WS_WBR), M, DM, RW, DM, DM};
        pg8::EpiMerge E{(const unsigned char*)a.out, (pg8::bf16_t*)(ws + WS_MG)};
        pg8::gemm_phase<pg8::EpiMerge, pg8::StaticOrderK2, true, true>(lds, g, S, E);
    }
    SEAM(5);
    if (IN(6)) {
        pg8::Gemm g{(const pg8::bf16_t*)(ws + WS_MG), (const pg8::bf16_t*)(ws + WS_WOUT), M, DM, DM, DM, DM};
        pg8::StaticOrder S; S.init(M, DM, G, bid);
        if (G == 256) {
            pg8::EpiOutNorm E{a.in[I_X], a.out, (float*)(ws + WS_ROWSS), (unsigned*)(ws + WS_PCNT), a.in[I_GFIN]};
            pg8::gemm_phase<pg8::EpiOutNorm, pg8::StaticOrder, false, true>(lds, g, S, E);
        }
    }
    if (rp == 8 && a.use_xb) for (int r_ = 0; r_ < rn; ++r_) xcd_barrier(xbar);
#undef IN
#undef SEAM
}

constexpr int N_PHASES = 7;
extern "C" void kernel_launch(void* const* d_in, const int* in_sizes, int n_in, void* d_out, int out_size, void* d_ws, size_t ws_size, hipStream_t stream) {
    static int grid = 0;
    if (grid == 0) {
        int dev = 0, cus = 0, per_cu = 0;
        (void)hipGetDevice(&dev);
        (void)hipDeviceGetAttribute(&cus, hipDeviceAttributeMultiprocessorCount, dev);
        if (hipFuncSetAttribute((const void*)mega, hipFuncAttributeMaxDynamicSharedMemorySize, LDS_BYTES) != hipSuccess) fprintf(stderr, "kernel_launch: hipFuncSetAttribute failed\n");
        if (hipOccupancyMaxActiveBlocksPerMultiprocessor(&per_cu, (const void*)mega, NT, LDS_BYTES) != hipSuccess || per_cu < 1) { fprintf(stderr, "kernel_launch: occupancy query says %d\n", per_cu); per_cu = 1; }
        (void)hipGetLastError();
        grid = cus > 0 ? cus : 256;
        fprintf(stderr, "kernel_launch: grid %d (per_cu %d)\n", grid, per_cu);
    }
    Args a{};
    for (int i = 0; i < 19; ++i) a.in[i] = (const float*)d_in[i];
    a.out = (float*)d_out; a.ws = (unsigned char*)d_ws;
    void* args[] = {&a};
    a.use_xb = 1;
    if (PROBE_LO < 0) {
        a.ph_lo = 0; a.ph_hi = N_PHASES; a.dry = (PROBE_REP_PHASE << 16) | (PROBE_REP << 12);
        (void)hipMemsetAsync((char*)d_ws + WS_BAR, 0, XCD_BAR_WORDS * 4, stream);
        hipError_t e = hipLaunchCooperativeKernel((const void*)mega, dim3(grid), dim3(NT), args, LDS_BYTES, stream);
        if (e != hipSuccess) fprintf(stderr, "kernel_launch: cooperative launch failed: %s\n", hipGetErrorString(e));
    } else {
#define PLAUNCH(l, h) do { (void)hipMemsetAsync((char*)d_ws + WS_BAR, 0, XCD_BAR_WORDS * 4, stream); a.ph_lo = (l); a.ph_hi = (h); (void)hipLaunchCooperativeKernel((const void*)mega, dim3(grid), dim3(NT), args, LDS_BYTES, stream); } while (0)
        if (PROBE_LO > 0) PLAUNCH(0, PROBE_LO);
        a.dry = PROBE_DRY; for (int r = 0; r < PROBE_N; ++r) PLAUNCH(PROBE_LO, PROBE_HI);
        a.dry = 0; PLAUNCH(PROBE_LO, N_PHASES);
    }
}
```

```cpp
#include <hip/hip_runtime.h>
#include <hip/hip_cooperative_groups.h>
#include <cstdio>
#include <cstdint>
namespace cg = cooperative_groups;
namespace pg8 {
#define PG8_LAS __attribute__((address_space(3)))
typedef unsigned short bf16_t;
typedef short bf16x8 __attribute__((ext_vector_type(8)));
typedef float f32x4 __attribute__((ext_vector_type(4)));
typedef unsigned u32x4 __attribute__((ext_vector_type(4)));
constexpr int BM = 256, BK = 64, HALF = 128, HTB = HALF * BK * 2  , STAGE_BYTES = 8 * HTB, NXCD = 8, WGM = 8;

__host__ __device__ __forceinline__ int lds_byte(int r, int c) { const int st = (r >> 4) * 2 + (c >> 5), rr = r & 15, cc = c & 31, ob = rr * 64 + cc * 2; return st * 1024 + (ob ^ (((ob >> 9) & 1) << 5)); }
__host__ __device__ __forceinline__ void stage_rc(int b, int& R, int& C) { const int st = b / 1024, sb = b % 1024, swz = sb ^ (((sb >> 9) & 1) << 5); R = (st >> 1) * 16 + swz / 64; C = (st & 1) * 32 + (swz % 64) / 2; }
__host__ __device__ __forceinline__ int perm32(int rho) { const int n = rho >> 4, i = rho & 15; return 8 * (i >> 2) + 4 * n + (i & 3); }

struct Unit { int pm, pn, kh; };
struct Gemm { const bf16_t* A; const bf16_t* Bt; int M, N, K, lda, ldb; };

struct StaticOrder {
    int nM, nN, nwg, G, c;
    __host__ __device__ void init(int M, int N, int G_, int c_) { nM = M / BM; nN = N / BM; nwg = nM * nN; G = G_; c = c_; }
    __host__ __device__ bool next(int i, Unit& u) const {
        const long L = (long)i * G + c; if (L >= nwg) return false;
        int wgid = (int)L; { const int q = nwg / NXCD, r = nwg % NXCD, xcd = wgid % NXCD, off = wgid / NXCD; wgid = (xcd < r ? xcd * (q + 1) : r * (q + 1) + (xcd - r) * q) + off; }
        const int nig = WGM * nN, gid = wgid / nig, fm = gid * WGM, gsz = (nM - fm) < WGM ? (nM - fm) : WGM;
        u.pm = fm + ((wgid % nig) % gsz); u.pn = (wgid % nig) / gsz; u.kh = 0; return true;
    }
    __device__ __forceinline__ void a_ready(const Unit&) const {}
    __device__ __forceinline__ void done(const Unit&) const {}
};

__device__ __forceinline__ unsigned cvt_pk_bf16(float lo, float hi) { unsigned r; asm volatile("v_cvt_pk_bf16_f32 %0, %1, %2" : "=v"(r) : "v"(lo), "v"(hi)); return r; }
typedef float f32x2 __attribute__((ext_vector_type(2)));
struct StaticOrderRev {
    StaticOrder so;
    __host__ __device__ void init(int M, int N, int G_, int c_) { so.init(M, N, G_, c_); }
    __host__ __device__ bool next(int i, Unit& u) const { if (!so.next(i, u)) return false; u.pn = so.nN - 1 - u.pn; return true; }
    __device__ __forceinline__ void a_ready(const Unit&) const {}
    __device__ __forceinline__ void done(const Unit&) const {}
};
struct StaticOrderK2 {
    StaticOrder so;
    __host__ __device__ void init(int M, int N, int G_, int c_) { so.init(M, N, G_, c_); }
    __host__ __device__ bool next(int i, Unit& u) const { if (!so.next(i >> 1, u)) return false; u.kh = i & 1; return true; }
    __device__ __forceinline__ void a_ready(const Unit&) const {}
    __device__ __forceinline__ void done(const Unit&) const {}
};
template <class Epi, class Sched, bool ALIGN_EPI = false, bool SP2 = false>
__device__ __forceinline__ void gemm_phase(PG8_LAS unsigned char* lds, const Gemm g, const Sched& S, const Epi& E) {
    const int tid = threadIdx.x, wid = __builtin_amdgcn_readfirstlane(tid >> 6), lane = tid & 63, wr = wid >> 2, wc = wid & 3, fr = lane & 15, fq = lane >> 4;
    const int K = g.K, nt = K / BK;
    unsigned voffA[2], voffB[2];
#pragma unroll
    for (int i = 0; i < 2; ++i) { int R, C; stage_rc(tid * 16 + i * 8192, R, C); const int Rb = Epi::PERM ? ((R & ~31) + perm32(R & 31)) : R;
        voffA[i] = (unsigned)(R * g.lda + C) * 2u; voffB[i] = (unsigned)(Rb * g.ldb + C) * 2u; }
    const size_t kstep = (size_t)(BK * 2);
    const size_t hstepA = (size_t)HALF * g.lda * 2, hstepB = (size_t)HALF * g.ldb * 2;
    const size_t tstepA = 2 * hstepA, tstepB = 2 * hstepB;
    const unsigned ldsw = (unsigned)wid * 1024u;
    const int aoff = lds_byte(wr * 64 + fr, fq * 8), boff = lds_byte(wc * 32 + fr, fq * 8);
#define PG8_SA(b, h) (((b) * 2 + (h)) * HTB)
#define PG8_SB(b, h) ((4 + (b) * 2 + (h)) * HTB)
#define PG8_STAGE(bufoff, gbase, voff) do { _Pragma("unroll") for (int _i = 0; _i < 2; ++_i) \
        __builtin_amdgcn_global_load_lds((const unsigned*)((const char*)(gbase) + (voff)[_i]), (PG8_LAS unsigned*)(lds + (bufoff) + ldsw + _i * 8192), 16, 0, 0); } while (0)
#define PG8_LDA(dst, b, h) do { _Pragma("unroll") for (int m = 0; m < 4; ++m) _Pragma("unroll") for (int k = 0; k < 2; ++k) dst[m][k] = *(const PG8_LAS bf16x8*)(lds + PG8_SA(b, h) + aoff + m * 2048 + k * 1024); } while (0)
#define PG8_LDB(dst, b, h) do { _Pragma("unroll") for (int n = 0; n < 2; ++n) _Pragma("unroll") for (int k = 0; k < 2; ++k) dst[n][k] = *(const PG8_LAS bf16x8*)(lds + PG8_SB(b, h) + boff + n * 2048 + k * 1024); } while (0)
#define PG8_MMA(ai, bj, At, Bt) do { __builtin_amdgcn_s_setprio(1); _Pragma("unroll") for (int m = 0; m < 4; ++m) _Pragma("unroll") for (int n = 0; n < 2; ++n) _Pragma("unroll") for (int k = 0; k < 2; ++k) \
        acc[ai][bj][m][n] = __builtin_amdgcn_mfma_f32_16x16x32_bf16(Bt[n][k], At[m][k], acc[ai][bj][m][n], 0, 0, 0); __builtin_amdgcn_s_setprio(0); } while (0)
#define PG8_WAIT_V(n) asm volatile("s_waitcnt vmcnt(" #n ")" ::: "memory")
#define PG8_WAIT_L(n) asm volatile("s_waitcnt lgkmcnt(" #n ")" ::: "memory")
#define PG8_BAR __builtin_amdgcn_s_barrier()
#define PG8_SCHED __builtin_amdgcn_sched_barrier(0)
    Unit cur, nxt; int ui = 0;
    if (!S.next(0, cur)) return;
    f32x4 acc[2][2][4][2];
#pragma unroll
    for (int a = 0; a < 2; ++a)
#pragma unroll
        for (int b = 0; b < 2; ++b)
#pragma unroll
            for (int m = 0; m < 4; ++m)
#pragma unroll
                for (int n = 0; n < 2; ++n) acc[a][b][m][n] = (f32x4){0.f, 0.f, 0.f, 0.f};
    bf16x8 At[4][2], B0[2][2], B1[2][2];
    const char* cA = (const char*)g.A + (size_t)cur.pm * tstepA + (size_t)cur.kh * K * 2; const char* cB = (const char*)g.Bt + (size_t)cur.pn * tstepB + (size_t)cur.kh * K * 2;
    S.a_ready(cur);
    if constexpr (SP2) {
        PG8_STAGE(PG8_SB(0, 0), cB, voffB); PG8_STAGE(PG8_SB(0, 1), cB + hstepB, voffB); PG8_STAGE(PG8_SA(0, 0), cA, voffA); PG8_STAGE(PG8_SA(0, 1), cA + hstepA, voffA);
        if (wr == 1) PG8_BAR;
        PG8_WAIT_V(2); PG8_BAR;
        PG8_STAGE(PG8_SB(1, 0), cB + kstep, voffB); PG8_STAGE(PG8_SA(1, 0), cA + kstep, voffA); PG8_STAGE(PG8_SB(1, 1), cB + hstepB + kstep, voffB);
        PG8_WAIT_V(6); PG8_BAR;
    } else {
        PG8_STAGE(PG8_SB(0, 0), cB, voffB); PG8_STAGE(PG8_SA(0, 0), cA, voffA); PG8_STAGE(PG8_SB(0, 1), cB + hstepB, voffB); PG8_STAGE(PG8_SA(0, 1), cA + hstepA, voffA);
        if (wr == 1) PG8_BAR;
        PG8_WAIT_V(4); PG8_BAR;
        PG8_STAGE(PG8_SB(1, 0), cB + kstep, voffB); PG8_STAGE(PG8_SA(1, 0), cA + kstep, voffA); PG8_STAGE(PG8_SB(1, 1), cB + hstepB + kstep, voffB);
        PG8_WAIT_V(6); PG8_BAR;
    }
    for (;;) {
        const bool has_next = S.next(ui + 1, nxt);
        const char* nA = has_next ? (const char*)g.A + (size_t)nxt.pm * tstepA + (size_t)nxt.kh * K * 2 : cA; const char* nB = has_next ? (const char*)g.Bt + (size_t)nxt.pn * tstepB + (size_t)nxt.kh * K * 2 : cB;
        for (int t = 0; t < nt; t += 2) {
            const bool last = (t == nt - 2);
            const char* a1 = cA + (size_t)(t + 1) * kstep;
            const char* a2 = last ? nA : cA + (size_t)(t + 2) * kstep; const char* b2 = last ? nB : cB + (size_t)(t + 2) * kstep;
            const char* a3 = a2 + kstep; const char* b3 = b2 + kstep;
            if (last && has_next) S.a_ready(nxt);
            if constexpr (SP2) {
            PG8_LDB(B0, 0, 0); PG8_LDB(B1, 0, 1); PG8_SCHED; PG8_LDA(At, 0, 0); PG8_STAGE(PG8_SA(1, 1), a1 + hstepA, voffA);
            PG8_WAIT_V(8); PG8_WAIT_L(0); PG8_BAR; PG8_MMA(0, 0, At, B0); PG8_MMA(0, 1, At, B1); PG8_BAR; PG8_SCHED;
            PG8_LDA(At, 0, 1); PG8_STAGE(PG8_SB(0, 0), b2, voffB); PG8_STAGE(PG8_SB(0, 1), b2 + hstepB, voffB); PG8_STAGE(PG8_SA(0, 0), a2, voffA);
            PG8_WAIT_V(8); PG8_WAIT_L(0); PG8_BAR; PG8_MMA(1, 0, At, B0); PG8_MMA(1, 1, At, B1); PG8_BAR; PG8_SCHED;
            PG8_LDB(B0, 1, 0); PG8_LDB(B1, 1, 1); PG8_SCHED; PG8_LDA(At, 1, 0); PG8_STAGE(PG8_SA(0, 1), a2 + hstepA, voffA);
            PG8_WAIT_V(8); PG8_WAIT_L(0); PG8_BAR; PG8_MMA(0, 0, At, B0); PG8_MMA(0, 1, At, B1); PG8_BAR; PG8_SCHED;
            PG8_LDA(At, 1, 1); PG8_STAGE(PG8_SB(1, 0), b3, voffB); PG8_STAGE(PG8_SB(1, 1), b3 + hstepB, voffB); PG8_STAGE(PG8_SA(1, 0), a3, voffA);
            PG8_WAIT_V(8); PG8_WAIT_L(0); PG8_BAR; PG8_MMA(1, 0, At, B0); PG8_MMA(1, 1, At, B1); PG8_BAR; PG8_SCHED;
            } else {
            PG8_LDB(B0, 0, 0); PG8_SCHED; PG8_LDA(At, 0, 0); PG8_STAGE(PG8_SA(1, 1), a1 + hstepA, voffA);
            PG8_WAIT_L(8); PG8_BAR; PG8_WAIT_L(0); PG8_MMA(0, 0, At, B0); PG8_BAR; PG8_SCHED;
            PG8_LDB(B1, 0, 1); PG8_STAGE(PG8_SB(0, 0), b2, voffB);
            PG8_BAR; PG8_WAIT_L(0); PG8_MMA(0, 1, At, B1); PG8_BAR;
            PG8_LDA(At, 0, 1); PG8_STAGE(PG8_SA(0, 0), a2, voffA);
            PG8_BAR; PG8_WAIT_L(0); PG8_MMA(1, 0, At, B0); PG8_BAR; PG8_SCHED;
            PG8_STAGE(PG8_SB(0, 1), b2 + hstepB, voffB);
            PG8_WAIT_V(6); PG8_BAR; PG8_MMA(1, 1, At, B1); PG8_BAR;
            PG8_LDB(B0, 1, 0); PG8_SCHED; PG8_LDA(At, 1, 0); PG8_STAGE(PG8_SA(0, 1), a2 + hstepA, voffA);
            PG8_WAIT_L(8); PG8_BAR; PG8_WAIT_L(0); PG8_MMA(0, 0, At, B0); PG8_BAR; PG8_SCHED;
            PG8_LDB(B1, 1, 1); PG8_STAGE(PG8_SB(1, 0), b3, voffB);
            PG8_BAR; PG8_WAIT_L(0); PG8_MMA(0, 1, At, B1); PG8_BAR;
            PG8_LDA(At, 1, 1); PG8_STAGE(PG8_SA(1, 0), a3, voffA);
            PG8_BAR; PG8_WAIT_L(0); PG8_MMA(1, 0, At, B0); PG8_BAR; PG8_SCHED;
            PG8_STAGE(PG8_SB(1, 1), b3 + hstepB, voffB);
            PG8_WAIT_V(6); PG8_BAR; PG8_MMA(1, 1, At, B1); PG8_BAR;
            }
        }
        if constexpr (ALIGN_EPI) { if (wr == 0) PG8_BAR; }
        if constexpr (!Epi::AFTER_DRAIN) { E(acc, cur, wr, wc, fr, fq); S.done(cur); }
        if (!has_next) break;
        if (!(Epi::KEEP && cur.kh == 0)) {
#pragma unroll
        for (int a = 0; a < 2; ++a)
#pragma unroll
            for (int b = 0; b < 2; ++b)
#pragma unroll
                for (int m = 0; m < 4; ++m)
#pragma unroll
                    for (int n = 0; n < 2; ++n) acc[a][b][m][n] = (f32x4){0.f, 0.f, 0.f, 0.f};
        }
        cur = nxt; cA = nA; cB = nB; ++ui;
        if constexpr (ALIGN_EPI) { if (wr == 1) PG8_BAR; }
    }
    PG8_WAIT_V(0);
    if constexpr (!ALIGN_EPI) { if (wr == 0) PG8_BAR; }
    PG8_BAR;
    if constexpr (Epi::AFTER_DRAIN) { E.fused(acc, cur, wr, wc, fr, fq, lds, wid, lane); S.done(cur); }
#undef PG8_SA
#undef PG8_SB
#undef PG8_STAGE
#undef PG8_LDA
#undef PG8_LDB
#undef PG8_MMA
#undef PG8_WAIT_V
#undef PG8_WAIT_L
#undef PG8_BAR
#undef PG8_SCHED
}
}

#define GAS __attribute__((address_space(1)))
#define LAS __attribute__((address_space(3)))
typedef unsigned short bf16;
typedef unsigned u32x4 __attribute__((ext_vector_type(4)));
typedef unsigned u32x2 __attribute__((ext_vector_type(2)));
typedef float f32x4 __attribute__((ext_vector_type(4)));
typedef float f32x16 __attribute__((ext_vector_type(16)));
typedef short bf16x8 __attribute__((ext_vector_type(8)));
typedef short s16x4 __attribute__((ext_vector_type(4)));

constexpr int NT = 512;
constexpr int BATCH = 2, SEQ = 8192, DM = 1024, M = BATCH * SEQ;
constexpr int NH = 8, HD = 64, RW = 512;
constexpr int SHW = 1664, INC = 5504, INCP = 5632;
constexpr int QKVW = 768;
constexpr int NCHUNK = SEQ / 64;
constexpr size_t MiB = 1u << 20;
constexpr size_t WS_ROWSS = 0;
constexpr size_t WS_BAR = 1024 * 1024;
constexpr size_t WS_PCNT = 1280 * 1024;
constexpr size_t WS_DUMMY = 1536 * 1024;
constexpr size_t WS_CT = 256 * 1024;
constexpr size_t WS_WBR = 2 * MiB, WS_WOUT = 4 * MiB, WS_WIN = 6 * MiB;
constexpr size_t WS_HB = 17 * MiB;
constexpr size_t WS_SH = 49 * MiB;
constexpr size_t WS_G = 101 * MiB;
constexpr size_t WS_QKV = 133 * MiB;
constexpr size_t WS_PS = 157 * MiB;
constexpr size_t WS_SL = 189 * MiB;
constexpr size_t WS_PY = 221 * MiB;
constexpr size_t WS_YL = 6 * MiB;
constexpr size_t WS_MG = WS_PS;
constexpr int LDS_BYTES = 147456;

struct Args {
    const float* in[19]; float* out; unsigned char* ws; int ph_lo, ph_hi, use_xb, dry;
};
enum { I_X = 0, I_GPRE, I_WIN, I_MU, I_W0, I_WDU, I_A0, I_WIU, I_KK, I_KA, I_RK, I_GNW, I_GNB, I_BQKV, I_SINKS, I_WBR, I_WBA, I_WOUT, I_GFIN };

typedef float f32x2_t __attribute__((ext_vector_type(2)));
typedef __bf16 bf16x2_t __attribute__((ext_vector_type(2)));
__device__ __forceinline__ unsigned pk2(float lo, float hi) { const f32x2_t v = {lo, hi}; const bf16x2_t b = __builtin_convertvector(v, bf16x2_t); return __builtin_bit_cast(unsigned, b); }
__device__ __forceinline__ unsigned f2bf(float f) { return pk2(f, 0.f) & 0xffffu; }
__device__ __forceinline__ float bf2f(unsigned short b) { return __builtin_bit_cast(float, (unsigned)b << 16); }
__device__ __forceinline__ float bflo(unsigned w) { return __builtin_bit_cast(float, w << 16); }
__device__ __forceinline__ float bfhi(unsigned w) { return __builtin_bit_cast(float, w & 0xffff0000u); }
__device__ __forceinline__ float dppx(float x, const int sel) {
    const int v = __builtin_bit_cast(int, x); int r;
    if (sel == 0) r = __builtin_amdgcn_update_dpp(0, v, 0xB1, 0xF, 0xF, true);
    else if (sel == 1) r = __builtin_amdgcn_update_dpp(0, v, 0x4E, 0xF, 0xF, true);
    else if (sel == 2) r = __builtin_amdgcn_update_dpp(0, v, 0x141, 0xF, 0xF, true);
    else r = __builtin_amdgcn_update_dpp(0, v, 0x140, 0xF, 0xF, true);
    return __builtin_bit_cast(float, r);
}
__device__ __forceinline__ float wave_sum(float v) {
    v += dppx(v, 0); v += dppx(v, 1); v += dppx(v, 2); v += dppx(v, 3);
    const int iv = __builtin_bit_cast(int, v);
    const float r0 = __builtin_bit_cast(float, __builtin_amdgcn_readlane(iv, 0)), r1 = __builtin_bit_cast(float, __builtin_amdgcn_readlane(iv, 16));
    const float r2 = __builtin_bit_cast(float, __builtin_amdgcn_readlane(iv, 32)), r3 = __builtin_bit_cast(float, __builtin_amdgcn_readlane(iv, 48));
    return (r0 + r1) + (r2 + r3);
}
__device__ __forceinline__ float sigmoidf_(float x) { return __builtin_amdgcn_rcpf(1.f + __expf(-x)); }
__device__ __forceinline__ float siluf_(float x) { return x * __builtin_amdgcn_rcpf(1.f + __expf(-x)); }

namespace pg8 {
struct EpiIn {
    static constexpr bool PERM = true, AFTER_DRAIN = false, MID = false, KEEP = false;
    bf16_t *SH, *G, *QKV, *GT; const float* bqkv;
    __device__ __forceinline__ void operator()(const f32x4 (&acc)[2][2][4][2], const Unit& u, int wr, int wc, int fr, int fq) const {
        const int row0 = u.pm * BM + wr * 64 + fr;
#pragma unroll
        for (int bj = 0; bj < 2; ++bj) {
            const int c128 = u.pn * 2 + bj;
            if (c128 >= 43) continue;
            const int col = c128 * 128 + wc * 32 + 8 * fq;
            int kind, ld, dcol; bf16_t* base;
            if (c128 < 13) { kind = 0; base = SH; ld = 1664; dcol = col; }
            else if (c128 < 17) { kind = 1; base = G; ld = 1024; dcol = col - 1664; }
            else if (c128 < 23) { kind = 2; base = QKV; ld = 768; dcol = col - 2176; }
            else if (c128 < 27) { kind = 1; base = G; ld = 1024; dcol = col - 2944 + 512; }
            else { kind = 3; base = GT; ld = 2048; dcol = col - 3456; }
            f32x4 b0 = {0.f, 0.f, 0.f, 0.f}, b1 = {0.f, 0.f, 0.f, 0.f}; float sc = 1.f;
            if (kind == 2) { b0 = *(const f32x4*)(bqkv + dcol); b1 = *(const f32x4*)(bqkv + dcol + 4); sc = dcol < 512 ? 0.125f : 1.f; }
#pragma unroll
            for (int ai = 0; ai < 2; ++ai)
#pragma unroll
                for (int m = 0; m < 4; ++m) {
                    f32x4 v0 = acc[ai][bj][m][0], v1 = acc[ai][bj][m][1];
                    if (kind == 1) {
#pragma unroll
                        for (int e = 0; e < 4; ++e) { v0[e] = v0[e] * sigmoidf_(v0[e]); v1[e] = v1[e] * sigmoidf_(v1[e]); }
                    } else if (kind == 2) { v0 = (v0 + b0) * sc; v1 = (v1 + b1) * sc; }
                    else if (kind == 3) {
#pragma unroll
                        for (int e = 0; e < 4; ++e) { v0[e] = sigmoidf_(v0[e]); v1[e] = sigmoidf_(v1[e]); }
                    }
                    if (kind == 3) {
                        u32x2 w8 = {0u, 0u};
#pragma unroll
                        for (int e = 0; e < 4; ++e) { w8.x = __builtin_amdgcn_cvt_pk_u8_f32(fmaxf(v0[e] * 255.f, 1.f), e, w8.x); w8.y = __builtin_amdgcn_cvt_pk_u8_f32(fmaxf(v1[e] * 255.f, 1.f), e, w8.y); }
                        *(u32x2*)((unsigned char*)GT + (size_t)(row0 + ai * HALF + m * 16) * 2048 + dcol) = w8;
                    } else {
                    u32x4 w; w.x = cvt_pk_bf16(v0[0], v0[1]); w.y = cvt_pk_bf16(v0[2], v0[3]); w.z = cvt_pk_bf16(v1[0], v1[1]); w.w = cvt_pk_bf16(v1[2], v1[3]);
                    *(u32x4*)(base + (size_t)(row0 + ai * HALF + m * 16) * ld + dcol) = w;
                    }
                }
        }
    }
};
struct EpiMerge {
    static constexpr bool PERM = true, AFTER_DRAIN = false, MID = false, KEEP = true;
    const unsigned char* GT; bf16_t* MG;
    __device__ __forceinline__ void operator()(f32x4 (&acc)[2][2][4][2], const Unit& u, int wr, int wc, int fr, int fq) const {
        const int row0 = u.pm * BM + wr * 64 + fr;
        if (u.kh == 0) {
#pragma unroll
            for (int ai = 0; ai < 2; ++ai)
#pragma unroll
                for (int m = 0; m < 4; ++m)
#pragma unroll
                    for (int bj = 0; bj < 2; ++bj) {
                        const unsigned char* gp = GT + (size_t)(row0 + ai * HALF + m * 16) * 2048 + u.pn * BM + bj * HALF + wc * 32 + 8 * fq;
                        const u32x2 gr = *(const u32x2*)gp, ga = *(const u32x2*)(gp + 1024);
#pragma unroll
                        for (int e = 0; e < 8; ++e) {
                            const float r_ = (float)(((e < 4 ? gr.x : gr.y) >> (8 * (e & 3))) & 0xffu), a_ = (float)(((e < 4 ? ga.x : ga.y) >> (8 * (e & 3))) & 0xffu);
                            acc[ai][bj][m][e >> 2][e & 3] *= r_ * __builtin_amdgcn_rcpf(a_);
                        }
                    }
        } else {
#pragma unroll
            for (int ai = 0; ai < 2; ++ai)
#pragma unroll
                for (int m = 0; m < 4; ++m)
#pragma unroll
                    for (int bj = 0; bj < 2; ++bj) {
                        const size_t r = (size_t)(row0 + ai * HALF + m * 16); const int c0 = u.pn * BM + bj * HALF + wc * 32 + 8 * fq;
                        const u32x2 ga = *(const u32x2*)(GT + r * 2048 + 1024 + c0);
                        float o[8];
#pragma unroll
                        for (int e = 0; e < 8; ++e) o[e] = acc[ai][bj][m][e >> 2][e & 3] * ((float)(((e < 4 ? ga.x : ga.y) >> (8 * (e & 3))) & 0xffu) * (1.f / 255.f));
                        u32x4 w; w.x = cvt_pk_bf16(o[0], o[1]); w.y = cvt_pk_bf16(o[2], o[3]); w.z = cvt_pk_bf16(o[4], o[5]); w.w = cvt_pk_bf16(o[6], o[7]);
                        *(u32x4*)(MG + r * 1024 + c0) = w;
                    }
        }
    }
};
struct EpiOutNorm {
    static constexpr bool PERM = false, AFTER_DRAIN = true, MID = false, KEEP = false;
    const float* x; float* out; float* rowss; unsigned* cnt; const float* gfin;
    __device__ __forceinline__ void fused(f32x4 (&acc)[2][2][4][2], const Unit& u, int wr, int wc, int fr, int fq, PG8_LAS unsigned char* lds, int wid, int lane) const {
#pragma unroll
        for (int ai = 0; ai < 2; ++ai)
#pragma unroll
            for (int m = 0; m < 4; ++m) {
                const int r = u.pm * BM + ai * HALF + wr * 64 + m * 16 + fr; float ss = 0.f;
#pragma unroll
                for (int bj = 0; bj < 2; ++bj)
#pragma unroll
                    for (int n = 0; n < 2; ++n) {
                        const size_t off = (size_t)r * 1024 + u.pn * BM + bj * HALF + wc * 32 + n * 16 + 4 * fq;
                        const f32x4 o = *(const f32x4*)(x + off) + acc[ai][bj][m][n];
                        acc[ai][bj][m][n] = o; ss += (o[0] * o[0] + o[1] * o[1]) + (o[2] * o[2] + o[3] * o[3]);
                    }
                ss += __shfl_xor(ss, 16); ss += __shfl_xor(ss, 32);
                if (fq == 0) atomicAdd(rowss + r, ss);
                if (m == 3) asm volatile("" ::: "memory");
            }
        asm volatile("s_waitcnt vmcnt(0)" ::: "memory");
        __syncthreads();
        if (threadIdx.x == 0) {
            __hip_atomic_fetch_add(cnt + 64 * u.pm, 1u, __ATOMIC_RELEASE, __HIP_MEMORY_SCOPE_AGENT);
            unsigned spins = 0;
            while (__hip_atomic_load(cnt + 64 * u.pm, __ATOMIC_ACQUIRE, __HIP_MEMORY_SCOPE_AGENT) < 4u) { __builtin_amdgcn_s_sleep(2); if (++spins > (1u << 22)) break; }
        }
        __syncthreads();
        f32x4 gf[2][2];
#pragma unroll
        for (int bj = 0; bj < 2; ++bj)
#pragma unroll
            for (int n = 0; n < 2; ++n) gf[bj][n] = *(const f32x4*)(gfin + u.pn * BM + bj * HALF + wc * 32 + n * 16 + 4 * fq);
        float ssr[8];
#pragma unroll
        for (int k = 0; k < 8; ++k) ssr[k] = __hip_atomic_load(rowss + u.pm * BM + (k >> 2) * HALF + wr * 64 + (k & 3) * 16 + fr, __ATOMIC_RELAXED, __HIP_MEMORY_SCOPE_AGENT);
#pragma unroll
        for (int ai = 0; ai < 2; ++ai)
#pragma unroll
            for (int m = 0; m < 4; ++m) {
                const int r = u.pm * BM + ai * HALF + wr * 64 + m * 16 + fr;
                const float sc = 1.f / sqrtf(ssr[ai * 4 + m] * (1.f / 1024.f) + 1e-6f);
#pragma unroll
                for (int bj = 0; bj < 2; ++bj)
#pragma unroll
                    for (int n = 0; n < 2; ++n) {
                        const int col = u.pn * BM + bj * HALF + wc * 32 + n * 16 + 4 * fq;
                        *(f32x4*)(out + (size_t)r * 1024 + col) = acc[ai][bj][m][n] * sc * gf[bj][n];
                    }
            }
    }
};
}

__device__ __forceinline__ void p0_transpose_item(const float* W, int N, bf16* WT, int ldo, int koff, LAS float* scr, int item, int lane) {
    const int nblk = N / 32, kb = item / nblk, nb = item % nblk, k0 = 64 * kb, n0 = 32 * nb;
    float wv[32];
#pragma unroll
    for (int i = 0; i < 32; ++i) wv[i] = W[(size_t)(k0 + 2 * i + (lane >> 5)) * N + n0 + (lane & 31)];
#pragma unroll
    for (int i = 0; i < 32; ++i) scr[(2 * i + (lane >> 5)) * 33 + (lane & 31)] = wv[i];
    asm volatile("s_waitcnt lgkmcnt(0)" ::: "memory");
    const int c = lane & 7;
#pragma unroll
    for (int j = 0; j < 4; ++j) { const int n = (lane >> 3) + 8 * j; const LAS float* s = scr + (8 * c) * 33 + n;
        u32x4 o; o.x = pk2(s[0 * 33], s[1 * 33]); o.y = pk2(s[2 * 33], s[3 * 33]); o.z = pk2(s[4 * 33], s[5 * 33]); o.w = pk2(s[6 * 33], s[7 * 33]);
        *(u32x4*)(WT + (size_t)(n0 + n) * ldo + koff + k0 + 8 * c) = o; }
    asm volatile("s_waitcnt lgkmcnt(0)" ::: "memory");
}
__device__ __forceinline__ void p0_prologue(const Args& a, LAS unsigned char* lds, int tid, int wave, int lane) {
    unsigned char* ws = a.ws;
    LAS float* scr = (LAS float*)(lds + wave * 16384);
    const int gw = blockIdx.x * 8 + wave, NGW = gridDim.x * 8;
    constexpr int I_IN = (DM / 64) * (INC / 32), I_BR = (RW / 64) * (DM / 32), I_O = (DM / 64) * (DM / 32);
    constexpr int NITEMS = I_IN + 2 * I_BR + I_O;
    for (int it = gw; it < NITEMS; it += NGW) {
        int r = it;
        if (r < I_IN) { p0_transpose_item(a.in[I_WIN], INC, (bf16*)(ws + WS_WIN), DM, 0, scr, r, lane); continue; } r -= I_IN;
        if (r < I_BR) { p0_transpose_item(a.in[I_WBR], DM, (bf16*)(ws + WS_WBR), DM, 0, scr, r, lane); continue; } r -= I_BR;
        if (r < I_BR) { p0_transpose_item(a.in[I_WBA], DM, (bf16*)(ws + WS_WBR), DM, RW, scr, r, lane); continue; } r -= I_BR;
        p0_transpose_item(a.in[I_WOUT], DM, (bf16*)(ws + WS_WOUT), DM, 0, scr, r, lane);
    }
    { const int gt = blockIdx.x * NT + tid, GT_ = gridDim.x * NT;
      u32x4* wp = (u32x4*)((bf16*)(ws + WS_WIN) + (size_t)INC * DM);
      for (int i = gt; i < (INCP - INC) * DM / 8; i += GT_) wp[i] = (u32x4){0u, 0u, 0u, 0u};
      float* rs = (float*)(ws + WS_ROWSS);
      for (int i = gt; i < M; i += GT_) rs[i] = 0.f;
      unsigned* pc = (unsigned*)(ws + WS_PCNT);
      for (int i = gt; i < 64 * 64; i += GT_) pc[i] = 0u; }
    const float* gp = a.in[I_GPRE];
    f32x4 gv[4];
#pragma unroll
    for (int j = 0; j < 4; ++j) gv[j] = ((const f32x4*)gp)[lane + 64 * j];
    for (int m = gw; m < M; m += 4 * NGW) {
        f32x4 v[4][4]; float s[4] = {0.f, 0.f, 0.f, 0.f};
#pragma unroll
        for (int q = 0; q < 4; ++q) { const f32x4* xr = (const f32x4*)(a.in[I_X] + (size_t)(m + q * NGW) * DM) + lane;
#pragma unroll
            for (int j = 0; j < 4; ++j) v[q][j] = xr[64 * j]; }
#pragma unroll
        for (int q = 0; q < 4; ++q)
#pragma unroll
            for (int j = 0; j < 4; ++j) s[q] += (v[q][j].x * v[q][j].x + v[q][j].y * v[q][j].y) + (v[q][j].z * v[q][j].z + v[q][j].w * v[q][j].w);
#pragma unroll
        for (int q = 0; q < 4; ++q) { const float sc = 1.f / sqrtf(wave_sum(s[q]) * (1.f / DM) + 1e-6f);
            unsigned long long* o8 = (unsigned long long*)((bf16*)(ws + WS_HB) + (size_t)(m + q * NGW) * DM) + lane;
#pragma unroll
            for (int j = 0; j < 4; ++j) { const f32x4 y = v[q][j] * sc * gv[j]; o8[64 * j] = (unsigned long long)pk2(y.x, y.y) | ((unsigned long long)pk2(y.z, y.w) << 32); } }
    }
}

__device__ __forceinline__ void attn_item(LAS unsigned char* lds, const Args& a, int b, int qb, int kvh, int tid, int wave, int lane, int dry) {
    LAS bf16* Ks = (LAS bf16*)lds;
    LAS bf16* Vt = (LAS bf16*)(lds + 36864);
    const bf16* QKV = (const bf16*)(a.ws + WS_QKV);
    bf16* G = (bf16*)(a.ws + WS_G);
    const long m0 = (long)b * SEQ + qb * 128;
    const int g = wave >> 1, qh = wave & 1, head = kvh * 4 + g;
    const int r = lane & 31, h = lane >> 5;
    u32x4 kv[4], vv[4];
#pragma unroll
    for (int i = 0; i < 4; ++i) {
        const int c = tid + i * NT, key = c >> 3, d8 = (c & 7) * 8; const long row = m0 - 128 + key;
        kv[i] = (u32x4){0u, 0u, 0u, 0u}; vv[i] = (u32x4){0u, 0u, 0u, 0u};
        if (qb > 0 || key >= 128) { kv[i] = *(const u32x4*)(QKV + row * QKVW + 512 + kvh * 64 + d8); vv[i] = *(const u32x4*)(QKV + row * QKVW + 640 + kvh * 64 + d8); }
    }
    bf16x8 qf[2][4];
#pragma unroll
    for (int s = 0; s < 4; ++s) qf[0][s] = *(const bf16x8*)(QKV + (m0 + qh * 64 + r) * QKVW + head * 64 + 8 * h + 16 * s);
#pragma unroll
    for (int i = 0; i < 4; ++i) {
        const int c = tid + i * NT, key = c >> 3, d8 = (c & 7) * 8;
        *(LAS u32x4*)(Ks + key * 72 + d8) = kv[i];
#pragma unroll
        for (int e = 0; e < 4; ++e) { const unsigned w = e == 0 ? vv[i].x : e == 1 ? vv[i].y : e == 2 ? vv[i].z : vv[i].w; Vt[(d8 + 2 * e) * 264 + key] = (bf16)(w & 0xffffu); Vt[(d8 + 2 * e + 1) * 264 + key] = (bf16)(w >> 16); }
    }
    __syncthreads();
    const float sink = a.in[I_SINKS][head];
#pragma unroll
    for (int qt = 0; qt < 2; ++qt) {
        const int q0 = qh * 64 + qt * 32, kt0 = q0 >> 5, qi = q0 + r;
        bf16* gp = G + (m0 + qi) * 1024 + 512 + head * 64;
        bf16* op = (dry & 1) ? (bf16*)(a.ws + 38 * MiB) + ((m0 + qi) & 4095) * 1024 + 512 + head * 64 : gp;
        u32x2 gt[8];
#pragma unroll
        for (int e = 0; e < 8; ++e) gt[e] = *(const u32x2*)(gp + (e >> 2) * 32 + 8 * (e & 3) + 4 * h);
        if (qt == 0) {
#pragma unroll
            for (int s = 0; s < 4; ++s) qf[1][s] = *(const bf16x8*)(QKV + (m0 + q0 + 32 + r) * QKVW + head * 64 + 8 * h + 16 * s);
        }
        f32x16 X[5];
#pragma unroll
        for (int kk = 0; kk < 5; ++kk) {
            f32x16 acc;
#pragma unroll
            for (int i = 0; i < 16; ++i) acc[i] = 0.f;
            const LAS bf16* kp = Ks + ((kt0 + kk) * 32 + r) * 72 + 8 * h;
#pragma unroll
            for (int s = 0; s < 4; ++s) { const bf16x8 kf = *(const LAS bf16x8*)(kp + 16 * s); acc = __builtin_amdgcn_mfma_f32_32x32x16_bf16(kf, qf[qt][s], acc, 0, 0, 0); }
            X[kk] = acc;
        }
        float mx = sink;
#pragma unroll
        for (int kk = 0; kk < 5; ++kk)
#pragma unroll
            for (int i = 0; i < 16; ++i) {
                const int kj = (kt0 + kk) * 32 + (i & 3) + 8 * (i >> 2) + 4 * h;
                const bool valid = (kj > qi) && (kj <= qi + 128) && (qb > 0 || kj >= 128);
                const float s = valid ? X[kk][i] : -1e30f; X[kk][i] = s; mx = fmaxf(mx, s);
            }
        mx = fmaxf(mx, __shfl_xor(mx, 32));
        float sum = 0.f;
#pragma unroll
        for (int kk = 0; kk < 5; ++kk)
#pragma unroll
            for (int i = 0; i < 16; ++i) { const float p = __expf(X[kk][i] - mx); X[kk][i] = p; sum += p; }
        sum += __shfl_xor(sum, 32); sum += __expf(sink - mx);
        const float inv = 1.f / sum;
        f32x16 O[2];
#pragma unroll
        for (int i = 0; i < 16; ++i) { O[0][i] = 0.f; O[1][i] = 0.f; }
#pragma unroll
        for (int kk = 0; kk < 5; ++kk)
#pragma unroll
            for (int s = 0; s < 2; ++s) {
                u32x4 pw; pw.x = pk2(X[kk][8 * s + 0], X[kk][8 * s + 1]); pw.y = pk2(X[kk][8 * s + 2], X[kk][8 * s + 3]); pw.z = pk2(X[kk][8 * s + 4], X[kk][8 * s + 5]); pw.w = pk2(X[kk][8 * s + 6], X[kk][8 * s + 7]);
                const bf16x8 pf = __builtin_bit_cast(bf16x8, pw);
#pragma unroll
                for (int dt = 0; dt < 2; ++dt) {
                    const LAS bf16* vp = Vt + (dt * 32 + r) * 264 + (kt0 + kk) * 32 + 16 * s + 4 * h;
                    const u32x2 v0 = *(const LAS u32x2*)vp, v1 = *(const LAS u32x2*)(vp + 8);
                    const u32x4 vw = {v0.x, v0.y, v1.x, v1.y};
                    O[dt] = __builtin_amdgcn_mfma_f32_32x32x16_bf16(__builtin_bit_cast(bf16x8, vw), pf, O[dt], 0, 0, 0);
                }
            }
#pragma unroll
        for (int dt = 0; dt < 2; ++dt)
#pragma unroll
            for (int g4 = 0; g4 < 4; ++g4) {
                const int d = dt * 32 + 8 * g4 + 4 * h;
                const u32x2 gv = gt[dt * 4 + g4];
                u32x2 o; o.x = pk2(O[dt][4 * g4 + 0] * inv * bflo(gv.x), O[dt][4 * g4 + 1] * inv * bfhi(gv.x)); o.y = pk2(O[dt][4 * g4 + 2] * inv * bflo(gv.y), O[dt][4 * g4 + 3] * inv * bfhi(gv.y));
                *(u32x2*)(op + d) = o;
            }
    }
    __syncthreads();
}

#define LBAR() asm volatile("s_waitcnt lgkmcnt(0)\n\ts_barrier" ::: "memory")
constexpr int LD = 65, SLOT = 64 * LD;
constexpr int RW_SMALL = 34176;
__device__ __forceinline__ f32x16 zero16() { f32x16 z;
#pragma unroll
    for (int i = 0; i < 16; ++i) z[i] = 0.f;
    return z; }
template <bool AT, bool BT>
__device__ __forceinline__ f32x16 mm32(const LAS float* A, const LAS float* B, int m0, int n0, int lane, f32x16 acc, int kbeg = 0, int kend = 64) {
    const int i = lane & 31, kh = lane >> 5;
#pragma unroll 8
    for (int k = kbeg; k < kend; k += 2) {
        const float av = AT ? A[(k + kh) * LD + m0 + i] : A[(m0 + i) * LD + k + kh];
        const float bv = BT ? B[(n0 + i) * LD + k + kh] : B[(k + kh) * LD + n0 + i];
        acc = __builtin_amdgcn_mfma_f32_32x32x2f32(av, bv, acc, 0, 0, 0);
    }
    return acc;
}
__device__ __forceinline__ int crow(int i, int h) { return (i & 3) + 8 * (i >> 2) + 4 * h; }
__device__ __forceinline__ float dpp_f(float x, const int ctrl_sel) {
    int v = __builtin_bit_cast(int, x), r;
    if (ctrl_sel == 0) r = __builtin_amdgcn_update_dpp(0, v, 0xB1, 0xF, 0xF, true);
    else if (ctrl_sel == 1) r = __builtin_amdgcn_update_dpp(0, v, 0x4E, 0xF, 0xF, true);
    else r = __builtin_amdgcn_update_dpp(0, v, 0x141, 0xF, 0xF, true);
    return __builtin_bit_cast(float, r);
}
__device__ __forceinline__ float sum8(float x) { x += dpp_f(x, 0); x += dpp_f(x, 1); x += dpp_f(x, 2); return x; }

__device__ __forceinline__ f32x16 mmb_fwd(const LAS bf16* A, const LAS bf16* B, int m0, int n0, int lane, f32x16 acc) {
    const LAS bf16* ap = A + (m0 + (lane & 31)) * 72 + 8 * (lane >> 5); const LAS bf16* bp = B + (n0 + (lane & 31)) * 72 + 8 * (lane >> 5);
#pragma unroll
    for (int s = 0; s < 4; ++s) acc = __builtin_amdgcn_mfma_f32_32x32x16_bf16(*(const LAS bf16x8*)(ap + 16 * s), *(const LAS bf16x8*)(bp + 16 * s), acc, 0, 0, 0);
    return acc;
}
struct RWP { u32x4 du_hi, du_lo, iu_hi, iu_lo; float mu_w, mu_a, mu_r, mu_k, mu_v, kkw, kaw, rkw, w0a0; };
__device__ __forceinline__ void rwp_load(RWP& p, const Args& a, int h, int wave, int lane) {
    const int ch = h * 64 + lane; float wdu[8], wiu[8], lo_[8];
#pragma unroll
    for (int tt = 0; tt < 8; ++tt) { const int i = 8 * wave + tt; wdu[tt] = a.in[I_WDU][(size_t)i * RW + ch]; wiu[tt] = a.in[I_WIU][(size_t)i * RW + ch]; }
#pragma unroll
    for (int tt = 0; tt < 8; ++tt) lo_[tt] = wdu[tt] - bf2f((bf16)f2bf(wdu[tt]));
    p.du_hi = (u32x4){pk2(wdu[0], wdu[1]), pk2(wdu[2], wdu[3]), pk2(wdu[4], wdu[5]), pk2(wdu[6], wdu[7])}; p.du_lo = (u32x4){pk2(lo_[0], lo_[1]), pk2(lo_[2], lo_[3]), pk2(lo_[4], lo_[5]), pk2(lo_[6], lo_[7])};
#pragma unroll
    for (int tt = 0; tt < 8; ++tt) lo_[tt] = wiu[tt] - bf2f((bf16)f2bf(wiu[tt]));
    p.w0a0 = a.in[(wave >> 2) ? I_A0 : I_W0][h * 64 + (wave & 1) * 32 + (lane & 31)];
    { const float* mu = a.in[I_MU]; p.mu_w = mu[1536 + lane]; p.mu_a = mu[1600 + lane]; p.mu_r = mu[ch]; p.mu_k = mu[512 + ch]; p.mu_v = mu[1024 + ch]; p.kkw = a.in[I_KK][ch]; p.kaw = a.in[I_KA][ch]; p.rkw = a.in[I_RK][ch]; }
    p.iu_hi = (u32x4){pk2(wiu[0], wiu[1]), pk2(wiu[2], wiu[3]), pk2(wiu[4], wiu[5]), pk2(wiu[6], wiu[7])}; p.iu_lo = (u32x4){pk2(lo_[0], lo_[1]), pk2(lo_[2], lo_[3]), pk2(lo_[4], lo_[5]), pk2(lo_[6], lo_[7])};
}
template <int MODE>
__device__ __forceinline__ void rw_prep(LAS float* X, const Args& a, int b, int h, int t0, int tid, int wave, int lane, int dry, const RWP& pw) {
    const bf16* SH = (const bf16*)(a.ws + WS_SH);
    const float* mu = a.in[I_MU];
    const int j = lane, ch = h * 64 + j;
    const size_t mrow = (size_t)b * SEQ + t0;
    const bf16* sh = SH + (mrow + 8 * wave) * SHW;
    const bool first = (t0 + 8 * wave == 0);
    LAS float* tot = X + RW_SMALL;
    LAS float* ctl = X + RW_SMALL + 512;
    bf16 rw_[9], ra_[9], rr_[9], rk_[9], rv_[9];
#pragma unroll
    for (int tt = 0; tt < 9; ++tt) {
        const bf16* p = sh + (long)(tt - 1) * SHW;
        const bool z = (tt == 0) && first;
        rw_[tt] = z ? (bf16)0 : p[1536 + j]; ra_[tt] = z ? (bf16)0 : p[1600 + j];
        rr_[tt] = z ? (bf16)0 : p[ch]; rk_[tt] = z ? (bf16)0 : p[512 + ch]; rv_[tt] = z ? (bf16)0 : p[1024 + ch];
    }
    const float mu_w = pw.mu_w, mu_a = pw.mu_a, mu_r = pw.mu_r, mu_k = pw.mu_k, mu_v = pw.mu_v;
    const float kkw = pw.kkw, kaw = pw.kaw, rkw = pw.rkw;
    {
        LAS bf16* Bq = (LAS bf16*)X;
#pragma unroll
        for (int tt = 0; tt < 8; ++tt) {
            const int t = 8 * wave + tt;
            const float pw = bf2f(rw_[tt + 1]), pa = bf2f(ra_[tt + 1]), qw = bf2f(rw_[tt]), qa = bf2f(ra_[tt]);
            const float xw = pw + (qw - pw) * mu_w;
            const float e2 = __expf(2.f * xw);
            Bq[0 * 4608 + t * 72 + j] = (bf16)f2bf(1.f - 2.f * __builtin_amdgcn_rcpf(e2 + 1.f));
            Bq[1 * 4608 + t * 72 + j] = (bf16)f2bf(pa + (qa - pa) * mu_a);
        }
        *(LAS u32x4*)(Bq + 2 * 4608 + j * 72 + 8 * wave) = pw.du_hi; *(LAS u32x4*)(Bq + 3 * 4608 + j * 72 + 8 * wave) = pw.du_lo;
        *(LAS u32x4*)(Bq + 4 * 4608 + j * 72 + 8 * wave) = pw.iu_hi; *(LAS u32x4*)(Bq + 5 * 4608 + j * 72 + 8 * wave) = pw.iu_lo;
    }
    LBAR();
    if (dry & 128) return;
    {
        const int hf = wave >> 2, mt = (wave >> 1) & 1, nt = wave & 1;
        LAS bf16* Bq = (LAS bf16*)X;
        f32x16 acc = mmb_fwd(Bq + hf * 4608, Bq + (2 + 2 * hf) * 4608, mt * 32, nt * 32, lane, zero16());
        acc = mmb_fwd(Bq + hf * 4608, Bq + (3 + 2 * hf) * 4608, mt * 32, nt * 32, lane, acc);
        const int col = nt * 32 + (lane & 31), hh = lane >> 5;
        if (hf == 0) {
            const float w0 = pw.w0a0;
#pragma unroll
            for (int i = 0; i < 16; ++i) {
                const float z = -(w0 + acc[i]);
                const float sp = z > 20.f ? z : __logf(1.f + __expf(z));
                X[4 * SLOT + (mt * 32 + crow(i, hh)) * LD + col] = -__expf(-sp - 0.5f);
            }
        } else {
            const float a0 = pw.w0a0;
#pragma unroll
            for (int i = 0; i < 16; ++i) X[5 * SLOT + (mt * 32 + crow(i, hh)) * LD + col] = __builtin_amdgcn_rcpf(1.f + __expf(-(a0 + acc[i])));
        }
    }
    LBAR();
    if (dry & 256) return;
    {
        float ldv[8], cs[8]; float run = 0.f;
#pragma unroll
        for (int tt = 0; tt < 8; ++tt) { ldv[tt] = X[4 * SLOT + (8 * wave + tt) * LD + j]; run += ldv[tt]; cs[tt] = run; }
        tot[wave * 64 + j] = run;
        LBAR();
        float off = 0.f, gC = 0.f;
#pragma unroll
        for (int w2 = 0; w2 < 8; ++w2) { const float v = tot[w2 * 64 + j]; off += (w2 < wave) ? v : 0.f; gC += v; }
        float tq[4][8]; float ctv = 0.f;
        float rr8[8], kkv8[8], km8[8], vx8[8], av8[8], xs[16];
#pragma unroll
        for (int tt = 0; tt < 8; ++tt) {
            const int t = 8 * wave + tt;
            const float r1 = bf2f(rr_[tt + 1]), k1 = bf2f(rk_[tt + 1]), v1 = bf2f(rv_[tt + 1]), r0 = bf2f(rr_[tt]), k0 = bf2f(rk_[tt]), v0 = bf2f(rv_[tt]);
            const float rr = r1 + (r0 - r1) * mu_r, kx = k1 + (k0 - k1) * mu_k;
            vx8[tt] = v1 + (v0 - v1) * mu_v;
            const float av = X[5 * SLOT + t * LD + j];
            const float kkv = kx * kkw, km = kx * (1.f + (av - 1.f) * kaw);
            rr8[tt] = rr; kkv8[tt] = kkv; km8[tt] = km; av8[tt] = av;
            xs[2 * tt] = kkv * kkv; xs[2 * tt + 1] = rr * km * rkw;
        }
        float tot16[16];
        {
            const bool b0 = (lane & 1) != 0, b1 = (lane & 2) != 0, b2 = (lane & 4) != 0, b3 = (lane & 8) != 0;
            float y[8], z[4], w2[2], u;
#pragma unroll
            for (int i = 0; i < 8; ++i) { const float lo = xs[i], hi = xs[i + 8]; y[i] = (b0 ? hi : lo) + dppx(b0 ? lo : hi, 0); }
#pragma unroll
            for (int i = 0; i < 4; ++i) { const float lo = y[i], hi = y[i + 4]; z[i] = (b1 ? hi : lo) + dppx(b1 ? lo : hi, 1); }
#pragma unroll
            for (int i = 0; i < 2; ++i) { const float lo = z[i], hi = z[i + 2]; w2[i] = (b2 ? hi : lo) + __builtin_bit_cast(float, __builtin_amdgcn_ds_swizzle(__builtin_bit_cast(int, b2 ? lo : hi), 0x101F)); }
            { const float lo = w2[0], hi = w2[1]; u = (b3 ? hi : lo) + __builtin_bit_cast(float, __builtin_amdgcn_ds_swizzle(__builtin_bit_cast(int, b3 ? lo : hi), 0x201F)); }
            u += __builtin_bit_cast(float, __builtin_amdgcn_ds_swizzle(__builtin_bit_cast(int, u), 0x401F));
            u += __shfl_xor(u, 32);
            const int iu = __builtin_bit_cast(int, u);
#pragma unroll
            for (int q = 0; q < 16; ++q) tot16[q] = __builtin_bit_cast(float, __builtin_amdgcn_readlane(iu, ((q >> 3) & 1) + 2 * ((q >> 2) & 1) + 4 * ((q >> 1) & 1) + 8 * (q & 1)));
        }
#pragma unroll
        for (int tt = 0; tt < 8; ++tt) {
            const int t = 8 * wave + tt;
            const float rr = rr8[tt], kkv = kkv8[tt], km = km8[tt], vx = vx8[tt], av = av8[tt];
            const float n2 = tot16[2 * tt], ct = tot16[2 * tt + 1];
            const float kap = kkv * __builtin_amdgcn_rsqf(fmaxf(n2, 1e-24f));
            const float be = kap * av;
            ctv = (lane == tt) ? ct : ctv;
            const float g = off + cs[tt];
            const float eg = __expf(g), egx = __expf(g - ldv[tt]), ieg = __expf(-g), ec = __expf(gC - g);
            LAS bf16* Bq = (LAS bf16*)X;
            Bq[0 * 4608 + t * 72 + j] = (bf16)f2bf(rr * eg); Bq[1 * 4608 + t * 72 + j] = (bf16)f2bf(kap * egx); Bq[3 * 4608 + t * 72 + j] = (bf16)f2bf(km * ieg); Bq[4 * 4608 + t * 72 + j] = (bf16)f2bf(be * ieg);
            tq[0][tt] = kap * egx; tq[1][tt] = vx; tq[2][tt] = km * ec; tq[3][tt] = be * ec;
        }
        if (lane < 8) { ctl[8 * wave + lane] = ctv; ((float*)(a.ws + WS_CT))[(mrow + 8 * wave + lane) * 8 + h] = ctv; }
        {
            LAS bf16* Bq = (LAS bf16*)X;
#pragma unroll
            for (int q = 0; q < 4; ++q) {
                u32x4 w; w.x = pk2(tq[q][0], tq[q][1]); w.y = pk2(tq[q][2], tq[q][3]); w.z = pk2(tq[q][4], tq[q][5]); w.w = pk2(tq[q][6], tq[q][7]);
                const int slot = q == 0 ? 2 * 4608 : q == 1 ? 5 * 4608 : q == 2 ? 6 * 4608 : 49920;
                *(LAS u32x4*)(Bq + slot + j * 72 + 8 * wave) = w;
            }
        }
        if (wave == 0) X[RW_SMALL + 576 + j] = __expf(gC);
    }
    LBAR();
}
__device__ __forceinline__ void rw_post(LAS float* X, const Args& a, int b, int h, int t0, int wave, int lane, const bf16 (&gt)[8], const float gw, const float gb, int dry) {
    bf16* G = (bf16*)(a.ws + WS_G);
    LAS float* ctl = X + RW_SMALL + 512;
    const int ch = h * 64 + lane;
    bf16* gp = G + ((size_t)b * SEQ + t0 + 8 * wave) * 1024 + ch;
    bf16* op = (dry & 1) ? (bf16*)(a.ws + 38 * MiB) + ((t0 + 8 * wave) & 4095) * 1024 + ch : gp;
#pragma unroll
    for (int tt = 0; tt < 8; ++tt) {
        const int t = 8 * wave + tt;
        const float y = X[5 * SLOT + t * LD + lane];
        const float mean = wave_sum(y) * (1.f / 64.f); const float d = y - mean;
        const float var = wave_sum(d * d) * (1.f / 64.f);
        const float o = d * __builtin_amdgcn_rsqf(var + 64e-5f) * gw + gb + ctl[t] * X[4 * SLOT + t * LD + lane];
        op[tt * 1024] = (bf16)f2bf(o * bf2f(gt[tt]));
    }
}
__device__ __forceinline__ unsigned pf_rw1(const Args& a, int item, int tid) {
    if (item >= 2048 || tid >= 325) return 0u;
    const int bh = item >> 7, c = item & 127, b = bh >> 3, h = bh & 7;
    const long m = (long)b * SEQ + c * 64 - 1 + tid / 5; const int sg = tid % 5;
    if (m < 0) return 0u;
    const int col = sg < 3 ? sg * 512 + h * 64 : 1536 + (sg - 3) * 64;
    return *(const unsigned*)((const bf16*)(a.ws + WS_SH) + m * SHW + col);
}
__device__ __forceinline__ unsigned pf_rw3(const Args& a, int item, int tid) {
    if (item >= 2048) return 0u;
    const int bh = item >> 7, c = item & 127, b = bh >> 3, h = bh & 7;
    const long mrow = (long)b * SEQ + c * 64;
    unsigned r = 0u;
    if (tid < 192) { const int w = tid >> 6, l = tid & 63;
        const char* p = w == 0 ? (const char*)((const bf16*)(a.ws + WS_SL) + (size_t)(item > 0 ? item - 1 : 0) * 4096) : w == 1 ? (const char*)((const bf16*)(a.ws + WS_YL) + (size_t)item * 4096) : (const char*)((const bf16*)(a.ws + WS_PY) + (size_t)item * 4096);
        r = *(const unsigned*)(p + l * 128); }
    else if (tid < 384) { }
    else { const int l = tid - 384;
        const long m = mrow + (l & 63);
        r = (l < 64) ? *(const unsigned*)((const bf16*)(a.ws + WS_G) + m * 1024 + h * 64) : *(const unsigned*)((const bf16*)(a.ws + WS_SH) + m * SHW + 1024 + h * 64); }
    return r;
}
__device__ __forceinline__ void pf_sink(const Args& a, unsigned v) { if (v == 0xDEADBEEFu) *(unsigned*)(a.ws + WS_DUMMY) = v; }

constexpr int BIMG = 4608;
constexpr int L_RT = 0, L_KT = BIMG, L_KTT = 2 * BIMG, L_KH = 3 * BIMG, L_BH = 4 * BIMG, L_VT = 5 * BIMG, L_KBT = 6 * BIMG;
constexpr int H_BBT = 49920, H_ABRT = 49920 + BIMG, H_AKK = 49920 + 2 * BIMG, H_TT = 49920 + 3 * BIMG;
constexpr int L_W1 = L_KH, L_W2 = L_BH, H_QYT = H_AKK, H_QST = H_TT;
__device__ __forceinline__ f32x16 mmb(const LAS bf16* A, const LAS bf16* B, int m0, int n0, int lane, f32x16 acc) {
    const LAS bf16* ap = A + (m0 + (lane & 31)) * 72 + 8 * (lane >> 5); const LAS bf16* bp = B + (n0 + (lane & 31)) * 72 + 8 * (lane >> 5);
#pragma unroll
    for (int s = 0; s < 4; ++s) acc = __builtin_amdgcn_mfma_f32_32x32x16_bf16(*(const LAS bf16x8*)(ap + 16 * s), *(const LAS bf16x8*)(bp + 16 * s), acc, 0, 0, 0);
    return acc;
}
__device__ __forceinline__ void st_t_lds(LAS bf16* dst, const f32x16& v, int m0, int col, int hh) {
#pragma unroll
    for (int g4 = 0; g4 < 4; ++g4) { u32x2 w; w.x = pk2(v[4 * g4], v[4 * g4 + 1]); w.y = pk2(v[4 * g4 + 2], v[4 * g4 + 3]); *(LAS u32x2*)(dst + col * 72 + m0 + 8 * g4 + 4 * hh) = w; }
}
__device__ __forceinline__ void st_t_glb(bf16* dst, const f32x16& v, int m0, int col, int hh) {
#pragma unroll
    for (int g4 = 0; g4 < 4; ++g4) { u32x2 w; w.x = pk2(v[4 * g4], v[4 * g4 + 1]); w.y = pk2(v[4 * g4 + 2], v[4 * g4 + 3]); *(u32x2*)(dst + col * 64 + m0 + 8 * g4 + 4 * hh) = w; }
}
__device__ __forceinline__ void rw1b_item(LAS float* X, const Args& a, int item, int tid, int wave, int lane, int dry, const RWP& pw) {
    const int bh = item >> 7, c = item & 127, b = bh >> 3, h = bh & 7;
    rw_prep<2>(X, a, b, h, c * 64, tid, wave, lane, dry, pw);
    if (dry & (16 | 128 | 256)) return;
    LAS bf16* Bq = (LAS bf16*)X; LAS float* XT = X + 4 * SLOT;
    const int hf = wave >> 2, m0 = ((wave >> 1) & 1) * 32, n0 = (wave & 1) * 32; int col = n0 + (lane & 31), hh = lane >> 5;
    asm volatile("" : "+v"(col), "+v"(hh));
    f32x16 acc1 = hf ? mmb(Bq + L_KT, Bq + L_KH, m0, n0, lane, zero16()) : mmb(Bq + L_BH, Bq + L_KT, m0, n0, lane, zero16());
    f32x16 acc2 = mmb(Bq + (hf ? L_KH : L_BH), Bq + L_RT, m0, n0, lane, zero16());
#pragma unroll
    for (int i = 0; i < 16; ++i) {
        const int row = m0 + crow(i, hh);
        acc2[i] = row <= col ? acc2[i] : 0.f;
        if (hf == 0) XT[row * LD + col] = row < col ? acc1[i] : 0.f; else acc1[i] = col < row ? acc1[i] : 0.f;
    }
    if (hf == 0) st_t_lds(Bq + H_ABRT, acc2, m0, col, hh); else st_t_lds(Bq + H_AKK, acc1, m0, col, hh);
    LBAR();
    if (!(dry & 32)) {
        const int lr = lane & 15, lq = lane >> 4;
        if (wave == 0) {
            int ii = lr; asm volatile("" : "+v"(ii)); const int base = lq * 16;
            float Tr[16];
#pragma unroll
            for (int t = 0; t < 16; ++t) {
                float s = (t == ii) ? 1.f : 0.f;
#pragma unroll
                for (int j = 0; j < t; ++j) s -= Tr[j] * XT[(base + j) * LD + base + t];
                Tr[t] = s;
            }
#pragma unroll
            for (int t = 0; t < 16; ++t) XT[(base + ii) * LD + base + t] = Tr[t];
        }
        LBAR();
        if (wave < 2) {
            const int base = 32 * wave;
            f32x4 x = {0.f, 0.f, 0.f, 0.f};
            float oa[4], ob[4];
#pragma unroll
            for (int s = 0; s < 4; ++s) { oa[s] = XT[(base + lr) * LD + base + 16 + 4 * s + lq]; ob[s] = XT[(base + 16 + 4 * s + lq) * LD + base + 16 + lr]; }
#pragma unroll
            for (int s = 0; s < 4; ++s) x = __builtin_amdgcn_mfma_f32_16x16x4f32(oa[s], ob[s], x, 0, 0, 0);
#pragma unroll
            for (int r = 0; r < 4; ++r) XT[(base + 4 * lq + r) * LD + base + 16 + lr] = x[r];
            f32x4 y = {0.f, 0.f, 0.f, 0.f};
#pragma unroll
            for (int s = 0; s < 4; ++s) { oa[s] = XT[(base + lr) * LD + base + 4 * s + lq]; ob[s] = XT[(base + 4 * s + lq) * LD + base + 16 + lr]; }
#pragma unroll
            for (int s = 0; s < 4; ++s) y = __builtin_amdgcn_mfma_f32_16x16x4f32(oa[s], ob[s], y, 0, 0, 0);
#pragma unroll
            for (int r = 0; r < 4; ++r) XT[(base + 4 * lq + r) * LD + base + 16 + lr] = -y[r];
        }
        LBAR();
        LAS float* XS = X + 5 * SLOT;
        const int tm = (wave >> 1) & 1, tn = wave & 1;
        if (wave < 4) {
            f32x4 x = {0.f, 0.f, 0.f, 0.f};
            float oa[8], ob[8];
#pragma unroll
            for (int s = 0; s < 8; ++s) { oa[s] = XT[(16 * tm + lr) * LD + 32 + 4 * s + lq]; ob[s] = XT[(32 + 4 * s + lq) * LD + 32 + 16 * tn + lr]; }
#pragma unroll
            for (int s = 0; s < 8; ++s) x = __builtin_amdgcn_mfma_f32_16x16x4f32(oa[s], ob[s], x, 0, 0, 0);
#pragma unroll
            for (int r = 0; r < 4; ++r) XS[(16 * tm + 4 * lq + r) * LD + 16 * tn + lr] = x[r];
        }
        LBAR();
        if (wave < 4) {
            f32x4 y = {0.f, 0.f, 0.f, 0.f};
            float oa[8], ob[8];
#pragma unroll
            for (int s = 0; s < 8; ++s) { oa[s] = XT[(16 * tm + lr) * LD + 4 * s + lq]; ob[s] = XS[(4 * s + lq) * LD + 16 * tn + lr]; }
#pragma unroll
            for (int s = 0; s < 8; ++s) y = __builtin_amdgcn_mfma_f32_16x16x4f32(oa[s], ob[s], y, 0, 0, 0);
#pragma unroll
            for (int r = 0; r < 4; ++r) XT[(16 * tm + 4 * lq + r) * LD + 32 + 16 * tn + lr] = -y[r];
        }
    }
    LBAR();
    {
        const int t = tid >> 3, jb = (tid & 7) * 8; float v[8];
#pragma unroll
        for (int e = 0; e < 8; ++e) v[e] = XT[(jb + e) * LD + t];
        u32x4 w; w.x = pk2(v[0], v[1]); w.y = pk2(v[2], v[3]); w.z = pk2(v[4], v[5]); w.w = pk2(v[6], v[7]);
        *(LAS u32x4*)(Bq + H_TT + t * 72 + jb) = w;
    }
    LBAR();
    if (dry & 64) return;
    acc1 = mmb(Bq + H_TT, Bq + (hf ? H_AKK : L_KTT), m0, n0, lane, zero16());
    st_t_lds(Bq + (hf ? L_W2 : L_W1), acc1, m0, col, hh);
    LBAR();
    acc1 = mmb(Bq + (hf ? L_W2 : L_W1), Bq + H_ABRT, m0, n0, lane, zero16());
    if (hf == 0) {
#pragma unroll
        for (int g4 = 0; g4 < 4; ++g4) { const u32x2 rv = *(const LAS u32x2*)(Bq + L_RT + col * 72 + m0 + 8 * g4 + 4 * hh);
            acc1[4 * g4] = bflo(rv.x) - acc1[4 * g4]; acc1[4 * g4 + 1] = bfhi(rv.x) - acc1[4 * g4 + 1]; acc1[4 * g4 + 2] = bflo(rv.y) - acc1[4 * g4 + 2]; acc1[4 * g4 + 3] = bfhi(rv.y) - acc1[4 * g4 + 3]; }
        st_t_glb((bf16*)(a.ws + WS_PY) + (size_t)item * 4096, acc1, m0, col, hh);
    } else {
#pragma unroll
        for (int i = 0; i < 16; ++i) acc1[i] = acc2[i] - acc1[i];
        st_t_lds(Bq + H_QYT, acc1, m0, col, hh);
    }
    LBAR();
    acc1 = mmb(Bq + (hf ? L_W2 : L_W1), Bq + H_BBT, m0, n0, lane, zero16());
    if (hf == 0) {
        const float gc = X[RW_SMALL + 576 + col];
#pragma unroll
        for (int i = 0; i < 16; ++i) acc1[i] = ((m0 + crow(i, hh)) == col ? gc : 0.f) - acc1[i];
        st_t_glb((bf16*)(a.ws + WS_PS) + (size_t)item * 4096, acc1, m0, col, hh);
    } else {
#pragma unroll
        for (int g4 = 0; g4 < 4; ++g4) { const u32x2 rv = *(const LAS u32x2*)(Bq + L_KBT + col * 72 + m0 + 8 * g4 + 4 * hh);
            acc1[4 * g4] = bflo(rv.x) - acc1[4 * g4]; acc1[4 * g4 + 1] = bfhi(rv.x) - acc1[4 * g4 + 1]; acc1[4 * g4 + 2] = bflo(rv.y) - acc1[4 * g4 + 2]; acc1[4 * g4 + 3] = bfhi(rv.y) - acc1[4 * g4 + 3]; }
        st_t_lds(Bq + H_QST, acc1, m0, col, hh);
    }
    LBAR();
    acc1 = mmb(Bq + L_VT, Bq + (hf ? H_QST : H_QYT), m0, n0, lane, zero16());
    if (hf == 0) st_t_glb((bf16*)(a.ws + WS_YL) + (size_t)item * 4096, acc1, m0, col, hh);
    else { bf16* o = (bf16*)(a.ws + WS_SL) + (size_t)item * 4096;
#pragma unroll
        for (int g4 = 0; g4 < 4; ++g4) { const int row = m0 + 8 * g4 + 4 * hh;
            u32x2 w; w.x = pk2(acc1[4 * g4], acc1[4 * g4 + 1]); w.y = pk2(acc1[4 * g4 + 2], acc1[4 * g4 + 3]);
            *(u32x2*)(o + ((((row >> 4) * 4 + (col >> 4)) * 64 + ((row >> 2) & 3) * 16 + (col & 15)) << 2)) = w; } }
    LBAR();
}
__device__ __forceinline__ void rw2b_scan(LAS float* X, const Args& a, int id, int tid, int wave, int lane, int dry) {
    const int bh = id >> 2, rg = id & 3;
    const bf16* PS = (const bf16*)(a.ws + WS_PS) + (size_t)bh * 128 * 4096;
    bf16* SL = (bf16*)(a.ws + WS_SL) + (size_t)bh * 128 * 4096;
    bf16* SLo = (dry & 1) ? (bf16*)(a.ws + 38 * MiB) + (size_t)(bh & 3) * 128 * 4096 : SL;
    LAS bf16* Sb = (LAS bf16*)X;
    for (int i = tid; i < 2 * 16 * 72 / 2; i += NT) ((LAS unsigned*)X)[i] = 0u;
    __syncthreads();
    const int n = wave & 3, lr = lane & 15, lq = lane >> 4;
    constexpr int D = 8;
    if (wave < 4) {
        bf16x8 pbv[D][2]; u32x2 iniv[D];
        const bf16* pbase = PS + (16 * n + lr) * 64 + 8 * lq;
        const size_t ioff = (size_t)((rg * 4 + n) * 64 + lane) * 4;
#pragma unroll
        for (int d = 0; d < D; ++d) { pbv[d][0] = *(const bf16x8*)(pbase + (size_t)d * 4096); pbv[d][1] = *(const bf16x8*)(pbase + (size_t)d * 4096 + 32); iniv[d] = *(const u32x2*)(SL + (size_t)d * 4096 + ioff); }
        for (int c0 = 0; c0 < NCHUNK; c0 += D) {
#pragma unroll
            for (int d = 0; d < D; ++d) {
                const int c = c0 + d;
                const LAS bf16* Sc = Sb + (d & 1) * 16 * 72; LAS bf16* Sn = Sb + ((d + 1) & 1) * 16 * 72;
                const bf16x8 a0 = *(const LAS bf16x8*)(Sc + lr * 72 + 8 * lq), a1 = *(const LAS bf16x8*)(Sc + lr * 72 + 32 + 8 * lq);
                f32x4 acc = {bflo(iniv[d].x), bfhi(iniv[d].x), bflo(iniv[d].y), bfhi(iniv[d].y)};
                acc = __builtin_amdgcn_mfma_f32_16x16x32_bf16(a0, pbv[d][0], acc, 0, 0, 0);
                acc = __builtin_amdgcn_mfma_f32_16x16x32_bf16(a1, pbv[d][1], acc, 0, 0, 0);
                u32x2 w; w.x = pk2(acc[0], acc[1]); w.y = pk2(acc[2], acc[3]);
                Sn[(4 * lq + 0) * 72 + 16 * n + lr] = (bf16)(w.x & 0xffffu); Sn[(4 * lq + 1) * 72 + 16 * n + lr] = (bf16)(w.x >> 16);
                Sn[(4 * lq + 2) * 72 + 16 * n + lr] = (bf16)(w.y & 0xffffu); Sn[(4 * lq + 3) * 72 + 16 * n + lr] = (bf16)(w.y >> 16);
                *(u32x2*)(SLo + (size_t)c * 4096 + ioff) = w;
                const int cn = c + D < NCHUNK ? c + D : NCHUNK - 1;
                pbv[d][0] = *(const bf16x8*)(pbase + (size_t)cn * 4096); pbv[d][1] = *(const bf16x8*)(pbase + (size_t)cn * 4096 + 32); iniv[d] = *(const u32x2*)(SL + (size_t)cn * 4096 + ioff);
                __syncthreads();
            }
        }
    } else {
        for (int c = 0; c < NCHUNK; ++c) __syncthreads();
    }
}
struct R3 { u32x4 s; u32x4 py; bf16 rv[9]; float ct, mu, gw, gb; u32x4 yl; bf16 gt[8]; };
__device__ __forceinline__ void rw3_load(R3& r, const Args& a, int item, int tid, int wave, int lane) {
    const int bh = item >> 7, c = item & 127, b = bh >> 3, h = bh & 7;
    const bf16* S0 = (const bf16*)(a.ws + WS_SL) + (size_t)(item > 0 ? item - 1 : 0) * 4096;
    const bf16* PY = (const bf16*)(a.ws + WS_PY) + (size_t)item * 4096;
    const bf16* YL = (const bf16*)(a.ws + WS_YL) + (size_t)item * 4096;
    const bf16* SH = (const bf16*)(a.ws + WS_SH);
    const size_t mrow = (size_t)b * SEQ + c * 64;
    const int v = tid >> 3, kb = (tid & 7) * 8, ch = h * 64 + lane;
    r.s = *(const u32x4*)(S0 + 8 * tid); r.yl = *(const u32x4*)(YL + 8 * tid);
    r.py = *(const u32x4*)(PY + v * 64 + kb);
#pragma unroll
    for (int tt = 0; tt < 9; ++tt) r.rv[tt] = (tt == 0 && c == 0 && wave == 0) ? (bf16)0 : SH[(mrow + 8 * wave + tt - 1) * SHW + 1024 + ch];
    r.ct = ((const float*)(a.ws + WS_CT))[(mrow + (tid & 63)) * 8 + h];
    r.mu = a.in[I_MU][1024 + ch]; r.gw = a.in[I_GNW][ch]; r.gb = a.in[I_GNB][ch];
    const bf16* gp = (const bf16*)(a.ws + WS_G) + (mrow + 8 * wave) * 1024 + ch;
#pragma unroll
    for (int tt = 0; tt < 8; ++tt) r.gt[tt] = gp[tt * 1024];
}
__device__ __forceinline__ void rw3_consume(const R3& r, LAS float* X, const Args& a, int item, int tid, int wave, int lane, int dry) {
    const int bh = item >> 7, c = item & 127, b = bh >> 3, h = bh & 7;
    LAS bf16* Bq = (LAS bf16*)X;
#pragma unroll
    for (int q = 0; q < 2; ++q) {
        const int e = 2 * tid + q, rg = e >> 8, n = (e >> 6) & 3, lq = (e >> 4) & 3, lr = e & 15, v0 = 16 * rg + 4 * lq, k = 16 * n + lr;
        const unsigned w0 = c > 0 ? (q ? r.s.z : r.s.x) : 0u, w1 = c > 0 ? (q ? r.s.w : r.s.y) : 0u;
        Bq[(v0 + 0) * 72 + k] = (bf16)(w0 & 0xffffu); Bq[(v0 + 1) * 72 + k] = (bf16)(w0 >> 16); Bq[(v0 + 2) * 72 + k] = (bf16)(w1 & 0xffffu); Bq[(v0 + 3) * 72 + k] = (bf16)(w1 >> 16);
    }
    {
        const int t = tid >> 3, vv = 8 * (tid & 7);
        X[5 * SLOT + t * LD + vv + 0] = bflo(r.yl.x); X[5 * SLOT + t * LD + vv + 1] = bfhi(r.yl.x); X[5 * SLOT + t * LD + vv + 2] = bflo(r.yl.y); X[5 * SLOT + t * LD + vv + 3] = bfhi(r.yl.y);
        X[5 * SLOT + t * LD + vv + 4] = bflo(r.yl.z); X[5 * SLOT + t * LD + vv + 5] = bfhi(r.yl.z); X[5 * SLOT + t * LD + vv + 6] = bflo(r.yl.w); X[5 * SLOT + t * LD + vv + 7] = bfhi(r.yl.w);
    }
    { const int v = tid >> 3, kb = (tid & 7) * 8; *(LAS u32x4*)(Bq + BIMG + v * 72 + kb) = r.py; }
    { const float mu_v = r.mu;
#pragma unroll
      for (int tt = 0; tt < 8; ++tt) { const float v1 = bf2f(r.rv[tt + 1]), v0 = bf2f(r.rv[tt]); X[4 * SLOT + (8 * wave + tt) * LD + lane] = v1 + (v0 - v1) * mu_v; } }
    if (tid < 64) X[RW_SMALL + 512 + tid] = r.ct;
    LBAR();
    if (wave < 4 && !(dry & 1024)) {
        const int m0 = ((wave >> 1) & 1) * 32, n0 = (wave & 1) * 32, col = n0 + (lane & 31), hh = lane >> 5;
        const f32x16 acc = mmb(Bq, Bq + BIMG, m0, n0, lane, zero16());
#pragma unroll
        for (int i = 0; i < 16; ++i) X[5 * SLOT + col * LD + m0 + crow(i, hh)] += acc[i];
    }
    LBAR();
    if (!(dry & 512)) rw_post(X, a, b, h, c * 64, wave, lane, r.gt, r.gw, r.gb, dry);
    LBAR();
}

__device__ __forceinline__ void final_norm(const Args& a, int wave, int lane) {
    const float* rs = (const float*)(a.ws + WS_ROWSS);
    const int gw = blockIdx.x * 8 + wave, NGW = gridDim.x * 8;
    f32x4 gv[4];
#pragma unroll
    for (int j = 0; j < 4; ++j) gv[j] = ((const f32x4*)a.in[I_GFIN])[lane + 64 * j];
    for (int m = gw; m < M; m += NGW) {
        const float sc = 1.f / sqrtf(rs[m] * (1.f / DM) + 1e-6f);
        f32x4* o = (f32x4*)(a.out + (size_t)m * DM) + lane;
#pragma unroll
        for (int j = 0; j < 4; ++j) o[64 * j] = o[64 * j] * sc * gv[j];
    }
}

#define XB_TMO      128
#define XB_XCNT(j)  (256  + 64 * (j))
#define XB_XSUB(j)  (1280 + 64 * (j))
#define XB_XGEN(j)  (2304 + 64 * (j))
#define XB_TOP      3328
#define XB_TOPGEN   3392
#define XCD_BAR_WORDS 3456
#define XB_SPIN_CAP (1u << 18)

__device__ __forceinline__ unsigned xb_ld(unsigned* p)              { return __hip_atomic_load(p, __ATOMIC_RELAXED, __HIP_MEMORY_SCOPE_AGENT); }
__device__ __forceinline__ unsigned xb_add(unsigned* p, unsigned v) { return __hip_atomic_fetch_add(p, v, __ATOMIC_RELAXED, __HIP_MEMORY_SCOPE_AGENT); }
__device__ __forceinline__ unsigned xb_xcc_id() { return (unsigned)__builtin_amdgcn_s_getreg((3 << 11) | 20) & 0xFu; }
#define XB_SPIN(cond, bar) do { unsigned _sp = 0; while (cond) { __builtin_amdgcn_s_sleep(1); \
    if ((++_sp & 255u) == 0u) { if (xb_ld(&(bar)[XB_TMO])) break; if (_sp > XB_SPIN_CAP) { atomicAdd(&(bar)[XB_TMO], 1u); break; } } } } while (0)

struct XcdBarrier {
    unsigned* bar; unsigned x;
    volatile LAS unsigned* st;
};

__device__ __forceinline__ XcdBarrier xcd_barrier_post(unsigned* bar, volatile LAS unsigned* st) {
    XcdBarrier b; b.bar = bar; b.x = xb_xcc_id(); b.st = st;
    if (threadIdx.x == 0) (void)xb_add(&bar[XB_XCNT(b.x)], 1u);
    return b;
}
__device__ __forceinline__ void xcd_barrier_complete(unsigned* bar, unsigned x, unsigned& nloc, unsigned& nx) {
    const unsigned G = gridDim.x * gridDim.y * gridDim.z;
    unsigned sum, cnt, mine, sp = 0u;
    for (;;) {
        sum = 0u; cnt = 0u; mine = 0u;
#pragma unroll
        for (unsigned j = 0; j < 16; ++j) { const unsigned c = xb_ld(&bar[XB_XCNT(j)]); sum += c; cnt += (c > 0u) ? 1u : 0u; mine = (j == x) ? c : mine; }
        if (sum == G) break;
        __builtin_amdgcn_s_sleep(1);
        if ((++sp & 255u) == 0u) { if (xb_ld(&bar[XB_TMO])) break; if (sp > XB_SPIN_CAP) { atomicAdd(&bar[XB_TMO], 1u); break; } }
    }
    nloc = mine > 0u ? mine : 1u; nx = cnt > 0u ? cnt : 1u;
}

__device__ __forceinline__ void xcd_barrier(const XcdBarrier& b) {
    asm volatile("s_waitcnt vmcnt(0)" ::: "memory");
    __syncthreads();
    if (threadIdx.x == 0) {
        unsigned* bar = b.bar;
        __builtin_amdgcn_s_waitcnt(0);
        unsigned nloc = b.st[0], nx = b.st[1];
        if (nloc == 0u) { xcd_barrier_complete(bar, b.x, nloc, nx); b.st[0] = nloc; b.st[1] = nx; }
        const unsigned old = xb_add(&bar[XB_XSUB(b.x)], 1u);
        const unsigned gen = old / nloc;
        if (old + 1u == (gen + 1u) * nloc) {
            __builtin_amdgcn_fence(__ATOMIC_RELEASE, "agent");
            asm volatile("s_waitcnt vmcnt(0)" ::: "memory");
            const unsigned og = xb_add(&bar[XB_TOP], 1u);
            const unsigned tg = og / nx;
            if (og + 1u == (tg + 1u) * nx) xb_add(&bar[XB_TOPGEN], 1u);
            else XB_SPIN(xb_ld(&bar[XB_TOPGEN]) == tg, bar);
            __builtin_amdgcn_fence(__ATOMIC_ACQUIRE, "agent");
            xb_add(&bar[XB_XGEN(b.x)], 1u);
            asm volatile("s_waitcnt vmcnt(0)" ::: "memory");
        } else {
            XB_SPIN(xb_ld(&bar[XB_XGEN(b.x)]) == gen, bar);
            __builtin_amdgcn_fence(__ATOMIC_ACQUIRE, "agent");
            asm volatile("s_waitcnt vmcnt(0)" ::: "memory");
        }
    }
    __syncthreads();
}

#define PROBE_REP_PHASE 0
#define PROBE_REP 0
#define PROBE_LO -1
#define PROBE_HI 0
#define PROBE_N 2
#define PROBE_DRY 0
__global__ void __launch_bounds__(NT, 2) mega(Args a) {
    extern __shared__ __attribute__((aligned(16))) unsigned char lds_raw[];
    LAS unsigned char* lds = (LAS unsigned char*)lds_raw;
    const int tid = threadIdx.x, lane = tid & 63, wave = __builtin_amdgcn_readfirstlane(tid >> 6);
    const int G = gridDim.x, bid = blockIdx.x;
    unsigned char* ws = a.ws;
    cg::grid_group grid = cg::this_grid();
    const int lo = a.ph_lo, hi = a.ph_hi;
#define IN(k) (lo <= (k) && (k) < hi)
#define SEAM(k) do { if (IN(k) && IN((k) + 1)) { if (a.use_xb) xcd_barrier(xbar); else grid.sync(); } } while (0)
    volatile LAS unsigned* xst = (volatile LAS unsigned*)(lds + LDS_BYTES - 64);
    if (tid < 2) xst[tid] = 0u;
    __syncthreads();
    unsigned* xbw = (unsigned*)(ws + WS_BAR);
    XcdBarrier xbar; xbar.bar = xbw; xbar.x = 0; xbar.st = xst;
    if (a.use_xb) xbar = xcd_barrier_post(xbw, xst);
    if (a.ph_hi > 1000) grid.sync();
    if (IN(0)) { p0_prologue(a, lds, tid, wave, lane); }
    SEAM(0);
    if (IN(1)) {
        pg8::Gemm g{(const pg8::bf16_t*)(ws + WS_HB), (const pg8::bf16_t*)(ws + WS_WIN), M, INCP, DM, DM, DM};
        pg8::StaticOrderRev S; S.init(M, INCP, G, bid);
        pg8::EpiIn E{(pg8::bf16_t*)(ws + WS_SH), (pg8::bf16_t*)(ws + WS_G), (pg8::bf16_t*)(ws + WS_QKV), (pg8::bf16_t*)a.out, a.in[I_BQKV]};
        pg8::gemm_phase<pg8::EpiIn, pg8::StaticOrderRev, true, true>(lds, g, S, E);
    }
    SEAM(1);
    const int rp = a.dry >> 16, rn = (a.dry >> 12) & 15; int dry = a.dry & 0xfff;
    if (IN(2)) for (int rep = (rp == 2 ? rn : 0); rep >= 0; --rep) {
        const int ist = G == 256 ? 1 : G, i0 = G == 256 ? bid * 8 : bid, iend = G == 256 ? bid * 8 + 8 : 2048;
        RWP pw; if (G == 256) rwp_load(pw, a, (i0 >> 7) & 7, wave, lane);
        for (int it = i0; it < iend; it += ist) { if (G != 256) rwp_load(pw, a, (it >> 7) & 7, wave, lane);
            const unsigned pf = 0u; rw1b_item((LAS float*)lds, a, it, tid, wave, lane, dry, pw); pf_sink(a, pf); }
    }
    SEAM(2);
    if (IN(3)) {
        const int d3 = dry;
        if (bid < 64) { const int sid = G == 256 ? (bid & 7) * 8 + (bid >> 3) : bid; if (!(d3 & 4)) rw2b_scan((LAS float*)lds, a, sid, tid, wave, lane, d3); }
        else if (!(d3 & 2)) {
            if (G == 256) { const int j = bid - 64, x = j & 7, q = j >> 3;
                { const int it = x * 24 + q; attn_item(lds, a, it >> 7, (it >> 1) & 63, it & 1, tid, wave, lane, d3); }
                if (j < 64) { const int it = 192 + x * 8 + q; attn_item(lds, a, it >> 7, (it >> 1) & 63, it & 1, tid, wave, lane, d3); } }
            else for (int it = bid - 64; it < 256; it += G - 64) attn_item(lds, a, it >> 7, (it >> 1) & 63, it & 1, tid, wave, lane, d3);
        }
    }
    SEAM(3);
    if (IN(4)) for (int rep = (rp == 4 ? rn : 0); rep >= 0; --rep) {
        const int d4 = dry | (rep > 0 ? 1 : 0);
        const int ist = G == 256 ? 1 : G, i0 = G == 256 ? bid * 8 : bid, iend = G == 256 ? bid * 8 + 8 : 2048;
        R3 cur; rw3_load(cur, a, i0, tid, wave, lane);
        for (int it = i0; it < iend; it += ist) {
            const unsigned pf = 0u;
            R3 nxt; rw3_load(nxt, a, it + ist < iend ? it + ist : it, tid, wave, lane);
            rw3_consume(cur, (LAS float*)lds, a, it, tid, wave, lane, d4);
            cur = nxt; pf_sink(a, pf);
        }
    }
    SEAM(4);
    if (IN(5)) {
        pg8::StaticOrderK2 S; S.init(M, DM, G, bid);
        pg8::Gemm g{(const pg8::bf16_t*)(ws + WS_G), (const pg8::bf16_t*)(ws + WS_WBR), M, DM, RW, DM, DM};
        pg8::EpiMerge E{(const unsigned char*)a.out, (pg8::bf16_t*)(ws + WS_MG)};
        pg8::gemm_phase<pg8::EpiMerge, pg8::StaticOrderK2, true, true>(lds, g, S, E);
    }
    SEAM(5);
    if (IN(6)) {
        pg8::Gemm g{(const pg8::bf16_t*)(ws + WS_MG), (const pg8::bf16_t*)(ws + WS_WOUT), M, DM, DM, DM, DM};
        pg8::StaticOrder S; S.init(M, DM, G, bid);
        if (G == 256) {
            pg8::EpiOutNorm E{a.in[I_X], a.out, (float*)(ws + WS_ROWSS), (unsigned*)(ws + WS_PCNT), a.in[I_GFIN]};
            pg8::gemm_phase<pg8::EpiOutNorm, pg8::StaticOrder, false, true>(lds, g, S, E);
        }
    }
    if (rp == 8 && a.use_xb) for (int r_ = 0; r_ < rn; ++r_) xcd_barrier(xbar);
#undef IN
#undef SEAM
}

constexpr int N_PHASES = 7;
extern "C" void kernel_launch(void* const* d_in, const int* in_sizes, int n_in, void* d_out, int out_size, void* d_ws, size_t ws_size, hipStream_t stream) {
    static int grid = 0;
    if (grid == 0) {
        int dev = 0, cus = 0, per_cu = 0;
        (void)hipGetDevice(&dev);
        (void)hipDeviceGetAttribute(&cus, hipDeviceAttributeMultiprocessorCount, dev);
        if (hipFuncSetAttribute((const void*)mega, hipFuncAttributeMaxDynamicSharedMemorySize, LDS_BYTES) != hipSuccess) fprintf(stderr, "kernel_launch: hipFuncSetAttribute failed\n");
        if (hipOccupancyMaxActiveBlocksPerMultiprocessor(&per_cu, (const void*)mega, NT, LDS_BYTES) != hipSuccess || per_cu < 1) { fprintf(stderr, "kernel_launch: occupancy query says %d\n", per_cu); per_cu = 1; }
        (void)hipGetLastError();
        grid = cus > 0 ? cus : 256;
        fprintf(stderr, "kernel_launch: grid %d (per_cu %d)\n", grid, per_cu);
    }
    Args a{};
    for (int i = 0; i < 19; ++i) a.in[i] = (const float*)d_in[i];
    a.out = (float*)d_out; a.ws = (unsigned char*)d_ws;
    void* args[] = {&a};
    a.use_xb = 1;
    if (PROBE_LO < 0) {
        a.ph_lo = 0; a.ph_hi = N_PHASES; a.dry = (PROBE_REP_PHASE << 16) | (PROBE_REP << 12);
        (void)hipMemsetAsync((char*)d_ws + WS_BAR, 0, XCD_BAR_WORDS * 4, stream);
        hipError_t e = hipLaunchCooperativeKernel((const void*)mega, dim3(grid), dim3(NT), args, LDS_BYTES, stream);
        if (e != hipSuccess) fprintf(stderr, "kernel_launch: cooperative launch failed: %s\n", hipGetErrorString(e));
    } else {
#define PLAUNCH(l, h) do { (void)hipMemsetAsync((char*)d_ws + WS_BAR, 0, XCD_BAR_WORDS * 4, stream); a.ph_lo = (l); a.ph_hi = (h); (void)hipLaunchCooperativeKernel((const void*)mega, dim3(grid), dim3(NT), args, LDS_BYTES, stream); } while (0)
        if (PROBE_LO > 0) PLAUNCH(0, PROBE_LO);
        a.dry = PROBE_DRY; for (int r = 0; r < PROBE_N; ++r) PLAUNCH(PROBE_LO, PROBE_HI);
        a.dry = 0; PLAUNCH(PROBE_LO, N_PHASES);
    }
}
```
